# Optimizing an MI355X kernel written in HIP

```python
import math
import jax, jax.numpy as jnp
from jax import lax
import numpy as np

D_MODEL = 1024
BATCH = 16
SEQ = 4096
DEPTH = 4

N_MIXERS = 2
N_RET_LAYERS = (DEPTH + 1) // 2
N_FNO_LAYERS = DEPTH // 2
RET_HEADS = 4
RET_DK = 256
RET_DV = 512
RET_QK = RET_HEADS * RET_DK
RET_V = RET_HEADS * RET_DV
RET_IN = 2 * RET_QK + 2 * RET_V
RET_CHUNK = 128
ROPE_BASE = 10000.0
FNO_GROUPS = 4
FNO_GROUP_DIM = D_MODEL // FNO_GROUPS
D_FF = ((8 * D_MODEL // 3 + 255) // 256) * 256
PLE_DIM = 256
NORM_EPS = 1e-6

kernel_name = "bidir_retention_fnet_hybrid"


def _rmsnorm(x, gain):
    xf = x.astype(jnp.float32)
    xf = xf * lax.rsqrt(jnp.mean(xf * xf, axis=-1, keepdims=True) + NORM_EPS)
    return (xf * gain.astype(jnp.float32)).astype(x.dtype)


def _rope(x, positions):
    half = x.shape[-1] // 2
    freq = 1.0 / (ROPE_BASE ** jnp.linspace(0.0, 1.0, half, dtype=jnp.float32))
    ang = positions.astype(jnp.float32)[..., None] * freq
    cos = jnp.cos(ang)[:, :, None, :].astype(x.dtype)
    sin = jnp.sin(ang)[:, :, None, :].astype(x.dtype)
    x1, x2 = x[..., :half], x[..., half:]
    return jnp.concatenate([x1 * cos - x2 * sin, x1 * sin + x2 * cos], axis=-1)


def _chunk_retention(q, k, v, log_gamma, strict):
    B, H, S, dk = q.shape
    dv = v.shape[-1]
    C = RET_CHUNK
    N = S // C
    qc = q.astype(jnp.float32).reshape(B, H, N, C, dk)
    kc = k.astype(jnp.float32).reshape(B, H, N, C, dk)
    vc = v.astype(jnp.float32).reshape(B, H, N, C, dv)
    lg = log_gamma[:, None]
    idx = jnp.arange(C, dtype=jnp.float32)
    diff = idx[:, None] - idx[None, :]
    mask = (diff > 0) if strict else (diff >= 0)
    decay = jnp.where(mask[None], jnp.exp(lg[:, :, None] * jnp.maximum(diff, 0.0)[None]), 0.0)
    scores = jnp.einsum('bhnid,bhnjd->bhnij', qc, kc) * decay[None, :, None]
    inner = jnp.einsum('bhnij,bhnje->bhnie', scores, vc)
    xi = jnp.exp(lg * (idx + 1.0))
    zeta = jnp.exp(lg * (C - 1.0 - idx))
    g_chunk = jnp.exp(lg * float(C))

    def step(R, xs):
        q_n, k_n, v_n = xs
        cross = jnp.einsum('bhcd,bhde->bhce', q_n, R) * xi[None, :, :, None]
        R_new = g_chunk[None, :, :, None] * R + jnp.einsum('bhcd,bhce->bhde', k_n, v_n * zeta[None, :, :, None])
        return R_new, cross

    R0 = jnp.zeros((B, H, dk, dv), jnp.float32)
    xs = (jnp.moveaxis(qc, 2, 0), jnp.moveaxis(kc, 2, 0), jnp.moveaxis(vc, 2, 0))
    _, cross = lax.scan(step, R0, xs)
    out = inner + jnp.moveaxis(cross, 0, 2)
    return out.reshape(B, H, S, dv)


def _retention_mixer(h, positions, w_in, w_out, gn_gain, decay_logit):
    B, S, _ = h.shape
    proj = h @ w_in
    q, k, v, g = jnp.split(proj, [RET_QK, 2 * RET_QK, 2 * RET_QK + RET_V], axis=-1)
    q = _rope(q.reshape(B, S, RET_HEADS, RET_DK), positions)
    k = _rope(k.reshape(B, S, RET_HEADS, RET_DK), positions) * (RET_DK ** -0.5)
    v = v.reshape(B, S, RET_HEADS, RET_DV)
    q, k, v = (t.transpose(0, 2, 1, 3) for t in (q, k, v))
    log_gamma = jax.nn.log_sigmoid(decay_logit.astype(jnp.float32))
    o_fwd = _chunk_retention(q, k, v, log_gamma[0], strict=False)
    o_bwd = jnp.flip(_chunk_retention(jnp.flip(q, 2), jnp.flip(k, 2), jnp.flip(v, 2), log_gamma[1], strict=True), axis=2)
    o = o_fwd + o_bwd
    mu = jnp.mean(o, axis=-1, keepdims=True)
    var = jnp.mean(jnp.square(o - mu), axis=-1, keepdims=True)
    o = (o - mu) * lax.rsqrt(var + NORM_EPS)
    o = o.transpose(0, 2, 1, 3).reshape(B, S, RET_V) * gn_gain.astype(jnp.float32)
    return (jax.nn.silu(g) * o.astype(h.dtype)) @ w_out


def _fourier_mixer(h, w_out):
    B, S, D = h.shape
    hg = h.astype(jnp.float32).reshape(B, S, FNO_GROUPS, FNO_GROUP_DIM)
    f = jnp.real(jnp.fft.fft2(hg, axes=(1, 3), norm='ortho'))
    return f.reshape(B, S, D).astype(h.dtype) @ w_out


def _swiglu(h, w_gate, w_up, w_down):
    return (jax.nn.silu(h @ w_gate) * (h @ w_up)) @ w_down


def setup_inputs(seed: int = 0) -> dict:
    key = jax.random.key(seed)
    ks = jax.random.split(key, 20)
    f32 = jnp.float32
    nrm = lambda k, shape, fan_in: jax.random.normal(k, shape, f32) * (fan_in ** -0.5)
    x = jax.random.normal(ks[0], (BATCH, SEQ, D_MODEL), f32)
    p = jax.random.normal(ks[1], (DEPTH, BATCH, SEQ, PLE_DIM), f32)
    positions = jnp.broadcast_to(jnp.arange(SEQ, dtype=jnp.int32)[None, :], (BATCH, SEQ))
    base_logit = (5.0 + jnp.arange(RET_HEADS, dtype=f32)) * math.log(2.0)
    ret_decay_logit = base_logit[None, None, :] + 0.1 * jax.random.normal(ks[2], (N_RET_LAYERS, 2, RET_HEADS), f32)
    return {
        "x": x,
        "p": p,
        "positions": positions,
        "norm_mix": 1.0 + 0.05 * jax.random.normal(ks[3], (DEPTH, D_MODEL), f32),
        "ret_w_in": nrm(ks[4], (N_RET_LAYERS, D_MODEL, RET_IN), D_MODEL),
        "ret_w_out": nrm(ks[5], (N_RET_LAYERS, RET_V, D_MODEL), RET_V),
        "ret_gn_gain": 1.0 + 0.05 * jax.random.normal(ks[6], (N_RET_LAYERS, RET_V), f32),
        "ret_decay_logit": ret_decay_logit,
        "fno_w_out": nrm(ks[7], (N_FNO_LAYERS, D_MODEL, D_MODEL), D_MODEL),
        "norm_ffn": 1.0 + 0.05 * jax.random.normal(ks[8], (DEPTH, D_MODEL), f32),
        "ffn_w_gate": nrm(ks[9], (DEPTH, D_MODEL, D_FF), D_MODEL),
        "ffn_w_up": nrm(ks[10], (DEPTH, D_MODEL, D_FF), D_MODEL),
        "ffn_w_down": nrm(ks[11], (DEPTH, D_FF, D_MODEL), D_FF),
        "norm_ple": 1.0 + 0.05 * jax.random.normal(ks[12], (DEPTH, D_MODEL), f32),
        "ple_w_gate": nrm(ks[13], (DEPTH, D_MODEL, D_MODEL), D_MODEL),
        "ple_w_proj": nrm(ks[14], (DEPTH, PLE_DIM, D_MODEL), PLE_DIM),
        "final_norm": 1.0 + 0.05 * jax.random.normal(ks[15], (D_MODEL,), f32),
    }


def reference(x, p, positions, norm_mix, ret_w_in, ret_w_out, ret_gn_gain, ret_decay_logit,
              fno_w_out, norm_ffn, ffn_w_gate, ffn_w_up, ffn_w_down,
              norm_ple, ple_w_gate, ple_w_proj, final_norm):
    for i in range(DEPTH):
        h = _rmsnorm(x, norm_mix[i])
        j = i // N_MIXERS
        if i % N_MIXERS == 0:
            x = x + _retention_mixer(h, positions, ret_w_in[j], ret_w_out[j], ret_gn_gain[j], ret_decay_logit[j])
        else:
            x = x + _fourier_mixer(h, fno_w_out[j])
        x = x + _swiglu(_rmsnorm(x, norm_ffn[i]), ffn_w_gate[i], ffn_w_up[i], ffn_w_down[i])
        gate = jax.nn.sigmoid(_rmsnorm(x, norm_ple[i]) @ ple_w_gate[i])
        x = x + gate * (p[i] @ ple_w_proj[i])
    return _rmsnorm(x, final_norm)
```

```cpp
#include <hip/hip_runtime.h>
#include <hip/hip_cooperative_groups.h>
#include <cstdio>
namespace cg = cooperative_groups;

#define LAS __attribute__((address_space(3)))
typedef unsigned short bf16_t;
typedef short bf16x8 __attribute__((ext_vector_type(8)));
typedef float f32x4 __attribute__((ext_vector_type(4)));
typedef float f32x2 __attribute__((ext_vector_type(2)));
typedef unsigned u32x4 __attribute__((ext_vector_type(4)));
typedef unsigned u32x2 __attribute__((ext_vector_type(2)));
typedef _Float16 h16x2 __attribute__((ext_vector_type(2)));

#ifndef COOP
#define COOP 1
#endif
#ifndef ONLY
#define ONLY -1
#endif
#define EX2(x) __builtin_amdgcn_exp2f(x)
#ifndef EXPDUP
#define EXPDUP -1
#endif
#define PHSEL(k) (ONLY < 0 || ONLY == (k))) for (int rep_ = 0; rep_ < ((EXPDUP) == (k) ? 2 : 1); ++rep_) if ((true)

constexpr int T = 65536, D = 1024, SEQ = 4096, DFF = 2816;
constexpr int TH = 32768;
constexpr size_t MiB = (size_t)1 << 20;
constexpr size_t WS_XB = 0;
constexpr size_t WS_W = 128 * MiB;
constexpr size_t WS_ROPE = 244 * MiB;
constexpr size_t WS_SSQ = 276 * MiB;
constexpr size_t WS_GST = 284 * MiB;
constexpr size_t WS_SCR = 292 * MiB;
constexpr size_t R_Q = 0, R_K = 64 * MiB, R_KTF = 128 * MiB, R_KTB = 192 * MiB, R_VTC = 256 * MiB, R_P = 384 * MiB, R_RF = 448 * MiB, R_RB = 576 * MiB;
constexpr size_t R_O = 64 * MiB;
constexpr size_t F_H = 0, F_PP = 352 * MiB, F_PB = 480 * MiB;
constexpr size_t Z_ZP = 0, Z_F = 256 * MiB, Z_D = 384 * MiB, Z_NY = 416 * MiB, Z_ST = 448 * MiB, Z_ZF = 576 * MiB;
constexpr size_t W_IN = 0;
constexpr size_t W_OUT = W_IN + 2 * 6291456;
constexpr size_t W_FNO = W_OUT + 2 * 2097152;
constexpr size_t W_DFT = W_FNO + 2 * 1048576;
constexpr size_t W_GU = W_DFT + 2 * 524288;
constexpr size_t W_DN = W_GU + 4 * 5767168;
constexpr size_t W_PG = W_DN + 4 * 2883584;
constexpr size_t W_PP = W_PG + 4 * 1048576;

struct Params {
    const float* x; const float* p; const int* pos; const float* norm_mix; const float* ret_w_in; const float* ret_w_out; const float* ret_gn; const float* ret_decay;
    const float* fno_w; const float* norm_ffn; const float* w_gate; const float* w_up; const float* w_down; const float* norm_ple; const float* ple_wg; const float* ple_wp; const float* final_norm;
    float* out; unsigned char* ws; int ph_lo, ph_hi;
};

__device__ __forceinline__ unsigned cvt_pk_bf16(float lo, float hi) { unsigned r; asm("v_cvt_pk_bf16_f32 %0, %1, %2" : "=v"(r) : "v"(lo), "v"(hi)); return r; }
__device__ __forceinline__ bf16_t f2bf(float f) { return (bf16_t)(cvt_pk_bf16(f, 0.f) & 0xffffu); }
__device__ __forceinline__ float bflo(unsigned w) { return __uint_as_float(w << 16); }
__device__ __forceinline__ float bfhi(unsigned w) { return __uint_as_float(w & 0xffff0000u); }
__device__ __forceinline__ float silu_f(float v) { return v * __builtin_amdgcn_rcpf(1.f + __expf(-v)); }
__device__ __forceinline__ float sigmoid_f(float v) { return __builtin_amdgcn_rcpf(1.f + __expf(-v)); }
__device__ __forceinline__ float lg2sig(float logit) { return -__log2f(1.f + __expf(-logit)); }
__device__ __forceinline__ float sum4(f32x4 v) { return (v[0] + v[1]) + (v[2] + v[3]); }
__device__ __forceinline__ float row_rstd(const float* ssq, int tok, int fq) {
    float s = sum4(*(const f32x4*)(ssq + (size_t)tok * 16 + fq * 4));
    s += __shfl_xor(s, 16); s += __shfl_xor(s, 32);
    return rsqrtf(s * (1.f / 1024.f) + 1e-6f);
}

struct PreNone { };
struct PreRs { float rs[8]; };
__device__ __forceinline__ void pre_rs(PreRs& P, const float* ssq, int row0, int wr, int fr, int fq) {
#pragma unroll
    for (int i = 0; i < 8; ++i) P.rs[i] = row_rstd(ssq, row0 + (i >> 2) * 128 + wr * 64 + (i & 3) * 16 + fr, fq);
#pragma unroll
    for (int i = 0; i < 8; ++i) asm volatile("" : "+v"(P.rs[i]));
}

constexpr int BM = 256, BK = 64, HALF = 128, HTB = HALF * BK * 2, STAGE_BYTES = 8 * HTB, NXCD = 8, WGM = 8;
__device__ __forceinline__ int lds_byte(int r, int c) { const int st = (r >> 4) * 2 + (c >> 5), rr = r & 15, cc = c & 31, ob = rr * 64 + cc * 2; return st * 1024 + (ob ^ (((ob >> 9) & 1) << 5)); }
__device__ __forceinline__ void stage_rc(int b, int& R, int& C) { const int st = b / 1024, sb = b % 1024, swz = sb ^ (((sb >> 9) & 1) << 5); R = (st >> 1) * 16 + swz / 64; C = (st & 1) * 32 + (swz % 64) / 2; }
__device__ __forceinline__ int perm32(int rho) { const int n = rho >> 4, i = rho & 15; return 8 * (i >> 2) + 4 * n + (i & 3); }
struct Unit { int pm, pn, z; };
__device__ __forceinline__ const char* uni(const char* p) { const unsigned long long v = (unsigned long long)p; const unsigned lo = __builtin_amdgcn_readfirstlane((unsigned)v), hi = __builtin_amdgcn_readfirstlane((unsigned)(v >> 32)); return (const char*)(((unsigned long long)hi << 32) | lo); }

template <class Epi, class Sched>
__device__ __forceinline__ void gemm_phase(LAS unsigned char* lds, const Sched& S, const Epi& E, const int lda, const int ldb, const int nt) {
    int tid = threadIdx.x; asm volatile("" : "+v"(tid));
    const int wid = __builtin_amdgcn_readfirstlane(tid >> 6), lane = tid & 63, wr = wid >> 2, wc = wid & 3, fr = lane & 15, fq = lane >> 4;
    unsigned voffA[2], voffB[2];
#pragma unroll
    for (int i = 0; i < 2; ++i) { int R, C; stage_rc(tid * 16 + i * 8192, R, C); const int Rb = Epi::PERM ? ((R & ~31) + perm32(R & 31)) : R;
        voffA[i] = (unsigned)(R * lda + C) * 2u; voffB[i] = (unsigned)(Rb * ldb + C) * 2u; }
    const size_t kstep = (size_t)(BK * 2);
    const size_t hstepA = (size_t)HALF * lda * 2, hstepB = (size_t)HALF * ldb * 2;
    const unsigned ldsbase = __builtin_amdgcn_readfirstlane((unsigned)(__UINTPTR_TYPE__)lds + (unsigned)wid * 1024u);
    const int aoff = lds_byte(wr * 64 + fr, fq * 8), boff = lds_byte(wc * 32 + fr, fq * 8);
#define G_SA(b, h) (((b) * 2 + (h)) * HTB)
#define G_SB(b, h) ((4 + (b) * 2 + (h)) * HTB)
#define G_STAGE(bufoff, gbase, voff) do { _Pragma("unroll") for (int _i = 0; _i < 2; ++_i) \
        asm volatile("s_mov_b32 m0, %0\n\ts_nop 0\n\tglobal_load_lds_dwordx4 %1, %2" :: "s"(ldsbase + (unsigned)((bufoff) + _i * 8192)), "v"((voff)[_i]), "s"((const char*)(gbase)) : "m0", "memory"); } while (0)
#define G_LDA(dst, b, h) do { _Pragma("unroll") for (int m = 0; m < 4; ++m) _Pragma("unroll") for (int k = 0; k < 2; ++k) dst[m][k] = *(const LAS bf16x8*)(lds + G_SA(b, h) + aoff + m * 2048 + k * 1024); } while (0)
#define G_LDB(dst, b, h) do { _Pragma("unroll") for (int n = 0; n < 2; ++n) _Pragma("unroll") for (int k = 0; k < 2; ++k) dst[n][k] = *(const LAS bf16x8*)(lds + G_SB(b, h) + boff + n * 2048 + k * 1024); } while (0)
#define G_MMA(ai, bj, At, Bt) do { __builtin_amdgcn_s_setprio(1); _Pragma("unroll") for (int m = 0; m < 4; ++m) _Pragma("unroll") for (int n = 0; n < 2; ++n) _Pragma("unroll") for (int k = 0; k < 2; ++k) \
        acc[ai][bj][m][n] = __builtin_amdgcn_mfma_f32_16x16x32_bf16(Bt[n][k], At[m][k], acc[ai][bj][m][n], 0, 0, 0); __builtin_amdgcn_s_setprio(0); } while (0)
#define G_WAIT_V(n) asm volatile("s_waitcnt vmcnt(" #n ")" ::: "memory")
#define G_WAIT_L(n) asm volatile("s_waitcnt lgkmcnt(" #n ")" ::: "memory")
#define G_BAR __builtin_amdgcn_s_barrier()
#define G_SCHED __builtin_amdgcn_sched_barrier(0)
    Unit cur, nxt; int ui = 0;
    if (!S.next(0, cur)) return;
    f32x4 acc[2][2][4][2];
#pragma unroll
    for (int a = 0; a < 2; ++a)
#pragma unroll
        for (int b = 0; b < 2; ++b)
#pragma unroll
            for (int m = 0; m < 4; ++m)
#pragma unroll
                for (int n = 0; n < 2; ++n) acc[a][b][m][n] = (f32x4){0.f, 0.f, 0.f, 0.f};
    bf16x8 At[4][2], B0[2][2], B1[2][2];
    const char* cA; const char* cB; S.ptrs(cur, cA, cB); cA = uni(cA); cB = uni(cB);
    typename Epi::Pre pre; E.pre_load(cur, wr, fr, fq, pre);
    G_STAGE(G_SB(0, 0), cB, voffB); G_STAGE(G_SA(0, 0), cA, voffA); G_STAGE(G_SB(0, 1), uni(cB + hstepB), voffB); G_STAGE(G_SA(0, 1), uni(cA + hstepA), voffA);
    if (wr == 1) G_BAR;
    G_WAIT_V(4); G_BAR;
    G_STAGE(G_SB(1, 0), uni(cB + kstep), voffB); G_STAGE(G_SA(1, 0), uni(cA + kstep), voffA); G_STAGE(G_SB(1, 1), uni(cB + hstepB + kstep), voffB);
    G_WAIT_V(6); G_BAR;
    for (;;) {
        const bool has_next = S.next(ui + 1, nxt);
        const char* nA = cA; const char* nB = cB; if (has_next) { S.ptrs(nxt, nA, nB); nA = uni(nA); nB = uni(nB); }
        for (int t = 0; t < nt; t += 2) {
            const bool last = (t == nt - 2);
            const char* a1 = uni(cA + (size_t)(t + 1) * kstep);
            const char* a2 = uni(last ? nA : cA + (size_t)(t + 2) * kstep); const char* b2 = uni(last ? nB : cB + (size_t)(t + 2) * kstep);
            const char* a3 = uni(a2 + kstep); const char* b3 = uni(b2 + kstep);
            const char* a1h = uni(a1 + hstepA); const char* a2h = uni(a2 + hstepA); const char* b2h = uni(b2 + hstepB); const char* b3h = uni(b3 + hstepB);
            G_LDB(B0, 0, 0); G_SCHED; G_LDA(At, 0, 0); G_STAGE(G_SA(1, 1), a1h, voffA);
            G_WAIT_L(8); G_BAR; G_WAIT_L(0); G_MMA(0, 0, At, B0); G_BAR; G_SCHED;
            G_LDB(B1, 0, 1); G_STAGE(G_SB(0, 0), b2, voffB);
            G_BAR; G_WAIT_L(0); G_MMA(0, 1, At, B1); G_BAR;
            G_LDA(At, 0, 1); G_STAGE(G_SA(0, 0), a2, voffA);
            G_BAR; G_WAIT_L(0); G_MMA(1, 0, At, B0); G_BAR; G_SCHED;
            G_STAGE(G_SB(0, 1), b2h, voffB);
            G_WAIT_V(6); G_BAR; G_MMA(1, 1, At, B1); G_BAR;
            G_LDB(B0, 1, 0); G_SCHED; G_LDA(At, 1, 0); G_STAGE(G_SA(0, 1), a2h, voffA);
            G_WAIT_L(8); G_BAR; G_WAIT_L(0); G_MMA(0, 0, At, B0); G_BAR; G_SCHED;
            G_LDB(B1, 1, 1); G_STAGE(G_SB(1, 0), b3, voffB);
            G_BAR; G_WAIT_L(0); G_MMA(0, 1, At, B1); G_BAR;
            G_LDA(At, 1, 1); G_STAGE(G_SA(1, 0), a3, voffA);
            G_BAR; G_WAIT_L(0); G_MMA(1, 0, At, B0); G_BAR; G_SCHED;
            G_STAGE(G_SB(1, 1), b3h, voffB);
            G_WAIT_V(6); G_BAR; G_MMA(1, 1, At, B1); G_BAR;
        }
        { int fr_o = fr, fq_o = fq; asm volatile("" : "+v"(fr_o), "+v"(fq_o)); E(acc, cur, wr, wc, fr_o, fq_o, pre); }
        if (!has_next) break;
        if (!Epi::KEEP) {
#pragma unroll
            for (int a = 0; a < 2; ++a)
#pragma unroll
                for (int b = 0; b < 2; ++b)
#pragma unroll
                    for (int m = 0; m < 4; ++m)
#pragma unroll
                        for (int n = 0; n < 2; ++n) acc[a][b][m][n] = (f32x4){0.f, 0.f, 0.f, 0.f};
        }
        cur = nxt; cA = nA; cB = nB; ++ui;
        E.pre_load(cur, wr, fr, fq, pre);
    }
    G_WAIT_V(0);
    if (wr == 0) G_BAR;
    G_BAR;
#undef G_SA
#undef G_SB
#undef G_STAGE
#undef G_LDA
#undef G_LDB
#undef G_MMA
#undef G_WAIT_V
#undef G_WAIT_L
#undef G_BAR
#undef G_SCHED
}

struct TileSched {
    const char* A; const char* B; size_t sA, sB; int nM, nN, nwg, G, c;
    __device__ __forceinline__ void init(const void* A_, const void* B_, int lda, int ldb, int nM_, int nN_) {
        A = (const char*)A_; B = (const char*)B_; sA = (size_t)BM * lda * 2; sB = (size_t)BM * ldb * 2; nM = nM_; nN = nN_; nwg = nM * nN; G = gridDim.x; c = blockIdx.x; }
    __device__ __forceinline__ bool next(int i, Unit& u) const {
        const long L = (long)i * G + c; if (L >= nwg) return false;
        int wgid = (int)L; { const int q = nwg / NXCD, r = nwg % NXCD, xcd = wgid % NXCD, off = wgid / NXCD; wgid = (xcd < r ? xcd * (q + 1) : r * (q + 1) + (xcd - r) * q) + off; }
        const int nig = WGM * nN, gid = wgid / nig, fm = gid * WGM, gsz = (nM - fm) < WGM ? (nM - fm) : WGM;
        u.pm = fm + ((wgid % nig) % gsz); u.pn = (wgid % nig) / gsz; u.z = 0; return true;
    }
    __device__ __forceinline__ void ptrs(const Unit& u, const char*& a, const char*& b) const { a = A + (size_t)u.pm * sA; b = B + (size_t)u.pn * sB; }
};
struct Z1Sched {
    const char* W; const char* X; int G, c;
    __device__ __forceinline__ bool next(int i, Unit& u) const { const int L = i * G + c; if (L >= 2048) return false; u.pm = L & 7; u.pn = L >> 3; u.z = 0; return true; }
    __device__ __forceinline__ void ptrs(const Unit& u, const char*& a, const char*& b) const { a = W + (size_t)u.pm * (256 * 256 * 2); b = X + (size_t)u.pn * (256 * 1024 * 2) + (size_t)(u.pm >> 1) * 512; }
};
struct ScanSched {
    const char* vtc; const char* kt; int dir; bool active;
    __device__ __forceinline__ bool next(int i, Unit& u) const { if (!active || i >= 16) return false; u.z = i; u.pm = dir ? 15 - i : i; u.pn = 0; return true; }
    __device__ __forceinline__ void ptrs(const Unit& u, const char*& a, const char*& b) const { a = vtc + (size_t)u.pm * (131072 * 2); b = kt + (size_t)u.pm * (65536 * 2); }
};
struct ScoreSched {
    const char* q; const char* k; int c, stride;
    __device__ __forceinline__ bool next(int i, Unit& u) const { if (c < 0) return false; const int L = i * stride + c; if (L >= 512) return false; u.pm = L; u.pn = 0; u.z = 0; return true; }
    __device__ __forceinline__ void ptrs(const Unit& u, const char*& a, const char*& b) const { a = q + (size_t)u.pm * (65536 * 2); b = k + (size_t)u.pm * (65536 * 2); }
};
struct OutSched {
    const char* scr; int G, c;
    __device__ __forceinline__ bool next(int i, Unit& u) const { const int k = i / 3; const int L = k * G + c; if (L >= 1024) return false; u.pm = L >> 1; u.pn = L & 1; u.z = i - k * 3; return true; }
    __device__ __forceinline__ void ptrs(const Unit& u, const char*& a, const char*& b) const {
        const size_t ro = ((size_t)u.pm * 512 + (size_t)u.pn * 256) * 256 * 2;
        const size_t z1 = (size_t)(u.z == 1), z2 = (size_t)(u.z == 2);
        a = scr + R_Q + z2 * (R_P - R_Q) + (size_t)u.pm * (65536 * 2);
        b = scr + R_RB - z1 * (R_RB - R_RF) - z2 * (R_RB - R_VTC) + ro; }
};

__device__ __forceinline__ void tr_write8(LAS unsigned char* tw, int r, int fq, const u32x4 w) {
#pragma unroll
    for (int i = 0; i < 8; ++i) { const unsigned v = w[i >> 1];
        *(LAS unsigned short*)(tw + (fq * 8 + i) * 128 + ((((r >> 3) ^ ((i ^ fq) & 7))) << 4) + (r & 7) * 2) = (unsigned short)((i & 1) ? (v >> 16) : (v & 0xffffu)); }
}
struct EpiR1 {
    typedef PreRs Pre;
    __device__ __forceinline__ void pre_load(const Unit& u, int wr, int fr, int fq, Pre& P) const { pre_rs(P, ssq, tok0 + u.pm * 256, wr, fr, fq); }
    static constexpr bool PERM = true, KEEP = false;
    const float* ssq; const unsigned* rope; const float* decay; bf16_t* q; bf16_t* k; bf16_t* ktf; bf16_t* ktb; bf16_t* vtc; int tok0; LAS unsigned char* tl;
    __device__ __forceinline__ void operator()(f32x4 (&acc)[2][2][4][2], const Unit& u, int wr, int wc, int fr, int fq, const Pre& pre) const {
        const int bl = u.pm >> 4, chunk = u.pm & 15, cbase = wc * 32 + fq * 8;
        LAS unsigned char* tw = tl + (wr * 4 + wc) * 4096;
        const int lane = fq * 16 + fr, tc = lane >> 3, jg = lane & 7;
        const float (&rsv)[8] = pre.rs;
        if (u.pn < 8) {
            const bool isk = u.pn >= 4; const int h = u.pn & 3;
            const float lgf = lg2sig(decay[h]), lgb = lg2sig(decay[4 + h]);
            bf16_t* dst = (isk ? k : q) + ((size_t)(bl * 4 + h) * 4096 + chunk * 256) * 256;
            const size_t tb = ((size_t)(bl * 4 + h) * 16 + chunk) * 65536;
#pragma unroll
            for (int ai = 0; ai < 2; ++ai) {
                u32x4 w2s[4];
#pragma unroll
                for (int m = 0; m < 4; ++m) {
                    if (m == 0) asm volatile("" ::: "memory");
                    const int j = ai * 128 + wr * 64 + m * 16 + fr; const int tok = tok0 + u.pm * 256 + j;
                    const float rs = rsv[ai * 4 + m];
                    const u32x4 r0 = *(const u32x4*)(rope + (size_t)tok * 128 + cbase), r1 = *(const u32x4*)(rope + (size_t)tok * 128 + cbase + 4);
                    float o1[8], o2[8];
#pragma unroll
                    for (int n = 0; n < 2; ++n)
#pragma unroll
                        for (int jj = 0; jj < 4; ++jj) {
                            const h16x2 cs = __builtin_bit_cast(h16x2, n == 0 ? r0[jj] : r1[jj]); const float c = (float)cs.x, s = (float)cs.y;
                            const float x1 = acc[ai][0][m][n][jj] * rs, x2 = acc[ai][1][m][n][jj] * rs;
                            o1[n * 4 + jj] = x1 * c - x2 * s; o2[n * 4 + jj] = x1 * s + x2 * c; }
                    u32x4 w1, w2;
                    w1.x = cvt_pk_bf16(o1[0], o1[1]); w1.y = cvt_pk_bf16(o1[2], o1[3]); w1.z = cvt_pk_bf16(o1[4], o1[5]); w1.w = cvt_pk_bf16(o1[6], o1[7]);
                    w2.x = cvt_pk_bf16(o2[0], o2[1]); w2.y = cvt_pk_bf16(o2[2], o2[3]); w2.z = cvt_pk_bf16(o2[4], o2[5]); w2.w = cvt_pk_bf16(o2[6], o2[7]);
                    *(u32x4*)(dst + (size_t)j * 256 + cbase) = w1; *(u32x4*)(dst + (size_t)j * 256 + cbase + 128) = w2;
                    if (isk) { tr_write8(tw, m * 16 + fr, fq, w1); w2s[m] = w2; }
                }
                if (isk) {
                    const int jb = ai * 128 + wr * 64 + jg * 8;
                    float zf[8], zb[8];
#pragma unroll
                    for (int i = 0; i < 8; ++i) { zf[i] = EX2(lgf * (float)(255 - jb - i)); zb[i] = EX2(lgb * (float)(jb + i)); }
#pragma unroll
                    for (int grp = 0; grp < 2; ++grp) {
                        if (grp == 1) {
#pragma unroll
                            for (int m = 0; m < 4; ++m) tr_write8(tw, m * 16 + fr, fq, w2s[m]);
                        }
#pragma unroll
                        for (int ps = 0; ps < 4; ++ps) {
                            const int c = ps * 8 + tc; const u32x4 rd = *(const LAS u32x4*)(tw + c * 128 + ((jg ^ ((tc ^ ps) & 7)) << 4));
                            const size_t e = tb + (size_t)(wc * 32 + grp * 128 + c) * 256 + jb;
                            u32x4 a, b;
#pragma unroll
                            for (int t = 0; t < 4; ++t) { const float lo = bflo(rd[t]), hi = bfhi(rd[t]);
                                a[t] = cvt_pk_bf16(lo * zf[2 * t], hi * zf[2 * t + 1]); b[t] = cvt_pk_bf16(lo * zb[2 * t], hi * zb[2 * t + 1]); }
                            __builtin_nontemporal_store(a, (u32x4*)(ktf + e)); __builtin_nontemporal_store(b, (u32x4*)(ktb + e)); }
                    }
                }
            }
        } else {
            const int h = (u.pn - 8) >> 1, eh = ((u.pn - 8) & 1) * 256;
            const size_t tb = ((size_t)(bl * 4 + h) * 16 + chunk) * 131072;
#pragma unroll
            for (int ai = 0; ai < 2; ++ai)
#pragma unroll
                for (int bj = 0; bj < 2; ++bj) {
#pragma unroll
                    for (int m = 0; m < 4; ++m) { const float rs = rsv[ai * 4 + m]; const f32x4 v0 = acc[ai][bj][m][0] * rs, v1 = acc[ai][bj][m][1] * rs;
                        u32x4 w; w.x = cvt_pk_bf16(v0[0], v0[1]); w.y = cvt_pk_bf16(v0[2], v0[3]); w.z = cvt_pk_bf16(v1[0], v1[1]); w.w = cvt_pk_bf16(v1[2], v1[3]);
                        tr_write8(tw, m * 16 + fr, fq, w); }
#pragma unroll
                    for (int ps = 0; ps < 4; ++ps) {
                        const int c = ps * 8 + tc; const u32x4 rd = *(const LAS u32x4*)(tw + c * 128 + ((jg ^ ((tc ^ ps) & 7)) << 4));
                        __builtin_nontemporal_store(rd, (u32x4*)(vtc + tb + (size_t)(eh + bj * 128 + wc * 32 + c) * 256 + ai * 128 + wr * 64 + jg * 8)); }
                }
        }
    }
};
struct EpiScore {
    typedef PreNone Pre;
    __device__ __forceinline__ void pre_load(const Unit& u, int wr, int fr, int fq, Pre& P) const {  }
    static constexpr bool PERM = true, KEEP = false;
    const float* decay; bf16_t* P;
    __device__ __forceinline__ void operator()(f32x4 (&acc)[2][2][4][2], const Unit& u, int wr, int wc, int fr, int fq, const Pre& pre) const {
        const int h = (u.pm >> 4) & 3; const float lgf = lg2sig(decay[h]), lgb = lg2sig(decay[4 + h]);
        bf16_t* dst = P + (size_t)u.pm * 65536;
#pragma unroll
        for (int ai = 0; ai < 2; ++ai)
#pragma unroll
            for (int m = 0; m < 4; ++m) {
                const int a = ai * 128 + wr * 64 + m * 16 + fr;
#pragma unroll
                for (int bj = 0; bj < 2; ++bj) {
                    const int b0 = bj * 128 + wc * 32 + fq * 8; float v[8];
#pragma unroll
                    for (int n = 0; n < 2; ++n)
#pragma unroll
                        for (int jj = 0; jj < 4; ++jj) { const float df = (float)(a - (b0 + n * 4 + jj)); const float dm = EX2(lgf * fmaxf(df, 0.f) + lgb * fmaxf(-df, 0.f)); v[n * 4 + jj] = acc[ai][bj][m][n][jj] * dm; }
                    u32x4 w; w.x = cvt_pk_bf16(v[0], v[1]); w.y = cvt_pk_bf16(v[2], v[3]); w.z = cvt_pk_bf16(v[4], v[5]); w.w = cvt_pk_bf16(v[6], v[7]);
                    *(u32x4*)(dst + (size_t)a * 256 + b0) = w; }
            }
    }
};
struct EpiScan {
    typedef PreNone Pre;
    __device__ __forceinline__ void pre_load(const Unit& u, int wr, int fr, int fq, Pre& P) const {  }
    static constexpr bool PERM = true, KEEP = true;
    bf16_t* rt; int dir; const float* dptr;
    __device__ __forceinline__ void operator()(f32x4 (&acc)[2][2][4][2], const Unit& u, int wr, int wc, int fr, int fq, const Pre& pre) const {
        const float g = EX2(256.f * lg2sig(*dptr));
        const int target = dir ? u.pm - 1 : u.pm + 1;
        if (target >= 0 && target < 16) {
            bf16_t* dst = rt + (size_t)target * 131072;
#pragma unroll
            for (int ai = 0; ai < 2; ++ai)
#pragma unroll
                for (int m = 0; m < 4; ++m) {
                    const int e = ai * 128 + wr * 64 + m * 16 + fr;
#pragma unroll
                    for (int bj = 0; bj < 2; ++bj) { const f32x4 v0 = acc[ai][bj][m][0], v1 = acc[ai][bj][m][1];
                        u32x4 w; w.x = cvt_pk_bf16(v0[0], v0[1]); w.y = cvt_pk_bf16(v0[2], v0[3]); w.z = cvt_pk_bf16(v1[0], v1[1]); w.w = cvt_pk_bf16(v1[2], v1[3]);
                        __builtin_nontemporal_store(w, (u32x4*)(dst + (size_t)e * 256 + bj * 128 + wc * 32 + fq * 8)); }
                }
        }
#pragma unroll
        for (int ai = 0; ai < 2; ++ai)
#pragma unroll
            for (int bj = 0; bj < 2; ++bj)
#pragma unroll
                for (int m = 0; m < 4; ++m)
#pragma unroll
                    for (int n = 0; n < 2; ++n) acc[ai][bj][m][n] *= g;
    }
};
struct EpiOut {
    typedef PreNone Pre;
    __device__ __forceinline__ void pre_load(const Unit& u, int wr, int fr, int fq, Pre& P) const {  }
    static constexpr bool PERM = true, KEEP = true;
    const float* decay; bf16_t* o; float* gst;
    __device__ __forceinline__ void operator()(f32x4 (&acc)[2][2][4][2], const Unit& u, int wr, int wc, int fr, int fq, const Pre& pre) const {
        const int bh = u.pm >> 4, chunk = u.pm & 15, h = bh & 3, bl = bh >> 2;
        const float lgf = lg2sig(decay[h]), lgb = lg2sig(decay[4 + h]);
        const float kf = u.z == 0 ? -lgf : (u.z == 1 ? lgf : 0.f), kb = u.z == 0 ? lgb : 0.f, kz = u.z == 2 ? 0.f : 1.f;
#pragma unroll
        for (int ai = 0; ai < 2; ++ai)
#pragma unroll
            for (int m = 0; m < 4; ++m) {
                const int a = ai * 128 + wr * 64 + m * 16 + fr;
                if (u.z == 2) {
                    const int tl = bl * 4096 + chunk * 256 + a;
                    float s1 = 0.f, s2 = 0.f;
#pragma unroll
                    for (int bj = 0; bj < 2; ++bj) { const f32x4 v0 = acc[ai][bj][m][0], v1 = acc[ai][bj][m][1];
                        s1 += sum4(v0) + sum4(v1); s2 += sum4(v0 * v0) + sum4(v1 * v1);
                        u32x4 w; w.x = cvt_pk_bf16(v0[0], v0[1]); w.y = cvt_pk_bf16(v0[2], v0[3]); w.z = cvt_pk_bf16(v1[0], v1[1]); w.w = cvt_pk_bf16(v1[2], v1[3]);
                        __builtin_nontemporal_store(w, (u32x4*)(o + (size_t)tl * 2048 + h * 512 + u.pn * 256 + bj * 128 + wc * 32 + fq * 8)); }
                    s1 += __shfl_xor(s1, 16); s1 += __shfl_xor(s1, 32); s2 += __shfl_xor(s2, 16); s2 += __shfl_xor(s2, 32);
                    if (fq == 0) *(f32x2*)(gst + (((size_t)tl * 4 + h) * 8 + u.pn * 4 + wc) * 2) = (f32x2){s1, s2};
                }
                const float sc = kz * EX2(kf * (float)(a + 1) + kb * (float)(256 - a));
#pragma unroll
                for (int bj = 0; bj < 2; ++bj)
#pragma unroll
                    for (int n = 0; n < 2; ++n) acc[ai][bj][m][n] *= sc;
                asm volatile("" ::: "memory");
            }
    }
};
struct EpiGate {
    typedef PreRs Pre;
    __device__ __forceinline__ void pre_load(const Unit& u, int wr, int fr, int fq, Pre& P) const { pre_rs(P, ssq, tok0 + u.pm * 256, wr, fr, fq); }
    static constexpr bool PERM = true, KEEP = false;
    const float* ssq; const float* gst; const float* gng; bf16_t* o; int tok0;
    __device__ __forceinline__ void operator()(f32x4 (&acc)[2][2][4][2], const Unit& u, int wr, int wc, int fr, int fq, const Pre& pre) const {
        const int h = u.pn >> 1, c0 = u.pn * 256 + wc * 32 + fq * 8;
        f32x4 gg[2][2];
#pragma unroll
        for (int bj = 0; bj < 2; ++bj) { gg[bj][0] = *(const f32x4*)(gng + c0 + bj * 128); gg[bj][1] = *(const f32x4*)(gng + c0 + bj * 128 + 4); }
        float rsv[8], muv[8], grv[8];
#pragma unroll
        for (int i = 0; i < 8; ++i) {
            const int tl = u.pm * 256 + (i >> 2) * 128 + wr * 64 + (i & 3) * 16 + fr;
            rsv[i] = pre.rs[i];
            const f32x4 st = *(const f32x4*)(gst + ((size_t)tl * 4 + h) * 16 + fq * 4);
            float s1 = st[0] + st[2], s2 = st[1] + st[3];
            s1 += __shfl_xor(s1, 16); s1 += __shfl_xor(s1, 32); s2 += __shfl_xor(s2, 16); s2 += __shfl_xor(s2, 32);
            muv[i] = s1 * (1.f / 512.f); grv[i] = rsqrtf(fmaxf(s2 * (1.f / 512.f) - muv[i] * muv[i], 0.f) + 1e-6f); }
#pragma unroll
        for (int ai = 0; ai < 2; ++ai)
#pragma unroll
            for (int m = 0; m < 4; ++m) {
                const int tl = u.pm * 256 + ai * 128 + wr * 64 + m * 16 + fr;
                if (m == 0) asm volatile("" ::: "memory");
                const float rs = rsv[ai * 4 + m], mu = muv[ai * 4 + m], gr = grv[ai * 4 + m];
#pragma unroll
                for (int bj = 0; bj < 2; ++bj) {
                    bf16_t* op = o + (size_t)tl * 2048 + c0 + bj * 128;
                    const u32x4 ov = *(const u32x4*)op; float y[8];
#pragma unroll
                    for (int n = 0; n < 2; ++n)
#pragma unroll
                        for (int jj = 0; jj < 4; ++jj) { const unsigned w = ov[n * 2 + (jj >> 1)]; const float oval = (jj & 1) ? bfhi(w) : bflo(w);
                            y[n * 4 + jj] = silu_f(acc[ai][bj][m][n][jj] * rs) * gg[bj][n][jj] * (oval - mu) * gr; }
                    u32x4 w; w.x = cvt_pk_bf16(y[0], y[1]); w.y = cvt_pk_bf16(y[2], y[3]); w.z = cvt_pk_bf16(y[4], y[5]); w.w = cvt_pk_bf16(y[6], y[7]);
                    *(u32x4*)op = w; }
            }
    }
};
template <bool GATED> struct EpiResid {
    static constexpr bool PERM = true, KEEP = false;
    typedef PreRs Pre;
    __device__ __forceinline__ void pre_load(const Unit& u, int wr, int fr, int fq, Pre& P) const { if (GATED) pre_rs(P, ssq_in, tok0 + u.pm * 256, wr, fr, fq); }
    const bf16_t* xin; bf16_t* xout; float* ssq_out; const float* ssq_in; const bf16_t* pp; int tok0; float* xf32;
    __device__ __forceinline__ void operator()(f32x4 (&acc)[2][2][4][2], const Unit& u, int wr, int wc, int fr, int fq, const Pre& pre) const {
        const int c0 = u.pn * 256 + wc * 32 + fq * 8;
#pragma unroll
        for (int ai = 0; ai < 2; ++ai) {
            u32x4 pv[4][2];
            if (GATED) {
#pragma unroll
                for (int m = 0; m < 4; ++m)
#pragma unroll
                    for (int bj = 0; bj < 2; ++bj) pv[m][bj] = *(const u32x4*)(pp + (size_t)(tok0 + u.pm * 256 + ai * 128 + wr * 64 + m * 16 + fr) * 1024 + c0 + bj * 128);
            }
#pragma unroll
            for (int m = 0; m < 4; ++m) {
                const int tok = tok0 + u.pm * 256 + ai * 128 + wr * 64 + m * 16 + fr;
                const float nrl = GATED ? -1.4426950408889634f * pre.rs[ai * 4 + m] : 0.f;
                f32x4 ssv = (f32x4){0.f, 0.f, 0.f, 0.f};
#pragma unroll
                for (int bj = 0; bj < 2; ++bj) {
                    const size_t off = (size_t)tok * 1024 + c0 + bj * 128;
                    const u32x4 xv = *(const u32x4*)(xin + off);
                    f32x4 v0 = (f32x4){bflo(xv.x), bfhi(xv.x), bflo(xv.y), bfhi(xv.y)}, v1 = (f32x4){bflo(xv.z), bfhi(xv.z), bflo(xv.w), bfhi(xv.w)};
                    if (GATED) {
                        const u32x4 pw = pv[m][bj];
                        const f32x4 p0 = (f32x4){bflo(pw.x), bfhi(pw.x), bflo(pw.y), bfhi(pw.y)}, p1 = (f32x4){bflo(pw.z), bfhi(pw.z), bflo(pw.w), bfhi(pw.w)};
                        const f32x4 t0 = acc[ai][bj][m][0] * nrl, t1 = acc[ai][bj][m][1] * nrl;
                        f32x4 e0, e1; e0[0] = EX2(t0[0]); e0[1] = EX2(t0[1]); e0[2] = EX2(t0[2]); e0[3] = EX2(t0[3]); e1[0] = EX2(t1[0]); e1[1] = EX2(t1[1]); e1[2] = EX2(t1[2]); e1[3] = EX2(t1[3]);
                        const f32x4 d0 = e0 + 1.0f, d1 = e1 + 1.0f;
                        f32x4 r0, r1; r0[0] = __builtin_amdgcn_rcpf(d0[0]); r0[1] = __builtin_amdgcn_rcpf(d0[1]); r0[2] = __builtin_amdgcn_rcpf(d0[2]); r0[3] = __builtin_amdgcn_rcpf(d0[3]);
                        r1[0] = __builtin_amdgcn_rcpf(d1[0]); r1[1] = __builtin_amdgcn_rcpf(d1[1]); r1[2] = __builtin_amdgcn_rcpf(d1[2]); r1[3] = __builtin_amdgcn_rcpf(d1[3]);
                        v0 += r0 * p0; v1 += r1 * p1; }
                    else { v0 += acc[ai][bj][m][0]; v1 += acc[ai][bj][m][1]; }
                    ssv += v0 * v0; ssv += v1 * v1;
                    if (GATED && xf32) { *(f32x4*)(xf32 + off) = v0; *(f32x4*)(xf32 + off + 4) = v1; }
                    else { u32x4 w; w.x = cvt_pk_bf16(v0[0], v0[1]); w.y = cvt_pk_bf16(v0[2], v0[3]); w.z = cvt_pk_bf16(v1[0], v1[1]); w.w = cvt_pk_bf16(v1[2], v1[3]); *(u32x4*)(xout + off) = w; } }
                float ss = sum4(ssv);
                ss += __shfl_xor(ss, 16); ss += __shfl_xor(ss, 32);
                if (fq == 0) ssq_out[(size_t)tok * 16 + u.pn * 4 + wc] = ss;
            }
            asm volatile("" ::: "memory");
        }
    }
};
struct EpiF1 {
    typedef PreRs Pre;
    __device__ __forceinline__ void pre_load(const Unit& u, int wr, int fr, int fq, Pre& P) const { pre_rs(P, ssq, u.pm * 256, wr, fr, fq); }
    static constexpr bool PERM = true, KEEP = false;
    const float* ssq; bf16_t* H;
    __device__ __forceinline__ void operator()(f32x4 (&acc)[2][2][4][2], const Unit& u, int wr, int wc, int fr, int fq, const Pre& pre) const {
#pragma unroll
        for (int ai = 0; ai < 2; ++ai)
#pragma unroll
            for (int m = 0; m < 4; ++m) {
                const int tok = u.pm * 256 + ai * 128 + wr * 64 + m * 16 + fr;
                const float rs = pre.rs[ai * 4 + m]; const float nrl = -1.4426950408889634f * rs, rs2 = rs * rs; f32x4 hv[2];
#pragma unroll
                for (int n = 0; n < 2; ++n) {
                    const f32x4 g4 = acc[ai][0][m][n], u4 = acc[ai][1][m][n]; const f32x4 t4 = g4 * nrl;
                    f32x4 e4; e4[0] = EX2(t4[0]); e4[1] = EX2(t4[1]); e4[2] = EX2(t4[2]); e4[3] = EX2(t4[3]);
                    const f32x4 d4 = e4 + 1.0f;
                    f32x4 r4; r4[0] = __builtin_amdgcn_rcpf(d4[0]); r4[1] = __builtin_amdgcn_rcpf(d4[1]); r4[2] = __builtin_amdgcn_rcpf(d4[2]); r4[3] = __builtin_amdgcn_rcpf(d4[3]);
                    hv[n] = (g4 * u4) * (r4 * rs2); }
                u32x4 w; w.x = cvt_pk_bf16(hv[0][0], hv[0][1]); w.y = cvt_pk_bf16(hv[0][2], hv[0][3]); w.z = cvt_pk_bf16(hv[1][0], hv[1][1]); w.w = cvt_pk_bf16(hv[1][2], hv[1][3]);
                __builtin_nontemporal_store(w, (u32x4*)(H + (size_t)tok * DFF + u.pn * 128 + wc * 32 + fq * 8));
            }
    }
};
template <bool ZMAP> struct EpiPlain {
    typedef PreNone Pre;
    __device__ __forceinline__ void pre_load(const Unit& u, int wr, int fr, int fq, Pre& P) const {  }
    static constexpr bool PERM = true, KEEP = false;
    bf16_t* C; int ldc;
    __device__ __forceinline__ void operator()(f32x4 (&acc)[2][2][4][2], const Unit& u, int wr, int wc, int fr, int fq, const Pre& pre) const {
#pragma unroll
        for (int ai = 0; ai < 2; ++ai)
#pragma unroll
            for (int m = 0; m < 4; ++m) {
                const int r = u.pm * 256 + ai * 128 + wr * 64 + m * 16 + fr;
                bf16_t* rowp = ZMAP ? C + ((size_t)(u.pn >> 2) * 4096 + r) * 1024 + (u.pn & 3) * 256 : C + (size_t)r * ldc + u.pn * 256;
#pragma unroll
                for (int bj = 0; bj < 2; ++bj) { const f32x4 v0 = acc[ai][bj][m][0], v1 = acc[ai][bj][m][1];
                    u32x4 w; w.x = cvt_pk_bf16(v0[0], v0[1]); w.y = cvt_pk_bf16(v0[2], v0[3]); w.z = cvt_pk_bf16(v1[0], v1[1]); w.w = cvt_pk_bf16(v1[2], v1[3]);
                    *(u32x4*)(rowp + bj * 128 + wc * 32 + fq * 8) = w; }
            }
    }
};
struct Z2Sched {
    const char* D; const char* Z; int G, c;
    __device__ __forceinline__ bool next(int i, Unit& u) const { const int r = i >> 1; const int L = r * G + c; if (L >= 512) return false; u.pm = L & 7; u.pn = L >> 3; u.z = (i & 1) | (r << 1); return true; }
    __device__ __forceinline__ void ptrs(const Unit& u, const char*& a, const char*& b) const {
        const size_t so = (size_t)(u.z & 1) * 4096;
        a = D + (size_t)u.pm * (256 * 4096 * 2) + so; b = Z + (size_t)u.pn * (256 * 4096 * 2) + so; }
};
struct EpiZ2 {
    typedef PreNone Pre;
    __device__ __forceinline__ void pre_load(const Unit& u, int wr, int fr, int fq, Pre& P) const {  }
    static constexpr bool PERM = true, KEEP = true;
    bf16_t* Fo; float* stash; const bf16_t* nyq;
    __device__ __forceinline__ void operator()(f32x4 (&acc)[2][2][4][2], const Unit& u, int wr, int wc, int fr, int fq, const Pre& pre) const {
        const int tid = (wr * 4 + wc) * 64 + fq * 16 + fr;
        float* st = stash + (size_t)(u.z >> 1) * 65536 + (size_t)tid * 4;
        if ((u.z & 1) == 0) {
#pragma unroll
            for (int ai = 0; ai < 2; ++ai)
#pragma unroll
                for (int m = 0; m < 4; ++m)
#pragma unroll
                    for (int bj = 0; bj < 2; ++bj)
#pragma unroll
                        for (int n = 0; n < 2; ++n) *(f32x4*)(st + (size_t)((((ai * 4 + m) * 2 + bj) * 2 + n) * 2048)) = acc[ai][bj][m][n];
        } else {
            const int b = u.pn >> 2, g = u.pn & 3;
            const float sgn = (fr & 1) ? -1.f : 1.f;
            f32x4 ny[2][2];
#pragma unroll
            for (int bj = 0; bj < 2; ++bj) { const u32x4 nv = *(const u32x4*)(nyq + (size_t)u.pn * 256 + bj * 128 + wc * 32 + fq * 8);
                ny[bj][0] = (f32x4){bflo(nv.x), bfhi(nv.x), bflo(nv.y), bfhi(nv.y)} * sgn; ny[bj][1] = (f32x4){bflo(nv.z), bfhi(nv.z), bflo(nv.w), bfhi(nv.w)} * sgn; }
#pragma unroll
            for (int ai = 0; ai < 2; ++ai)
#pragma unroll
                for (int m = 0; m < 4; ++m) {
                    const int kk = u.pm * 256 + ai * 128 + wr * 64 + m * 16 + fr;
                    bf16_t* r1 = Fo + ((size_t)b * 4096 + kk) * 1024 + g * 256 + wc * 32 + fq * 8;
                    bf16_t* r2 = Fo + ((size_t)b * 4096 + (4096 - kk)) * 1024 + g * 256 + wc * 32 + fq * 8;
#pragma unroll
                    for (int bj = 0; bj < 2; ++bj) {
                        const f32x4 c0 = *(const f32x4*)(st + (size_t)((((ai * 4 + m) * 2 + bj) * 2 + 0) * 2048)) + ny[bj][0], c1 = *(const f32x4*)(st + (size_t)((((ai * 4 + m) * 2 + bj) * 2 + 1) * 2048)) + ny[bj][1];
                        const f32x4 s0 = acc[ai][bj][m][0], s1 = acc[ai][bj][m][1];
                        const f32x4 p0 = c0 + s0, p1 = c1 + s1, q0 = c0 - s0, q1 = c1 - s1;
                        u32x4 w; w.x = cvt_pk_bf16(p0[0], p0[1]); w.y = cvt_pk_bf16(p0[2], p0[3]); w.z = cvt_pk_bf16(p1[0], p1[1]); w.w = cvt_pk_bf16(p1[2], p1[3]);
                        *(u32x4*)(r1 + bj * 128) = w;
                        u32x4 x; x.x = cvt_pk_bf16(q0[0], q0[1]); x.y = cvt_pk_bf16(q0[2], q0[3]); x.z = cvt_pk_bf16(q1[0], q1[1]); x.w = cvt_pk_bf16(q1[2], q1[3]);
                        if (kk != 0) *(u32x4*)(r2 + bj * 128) = x; }
                    if (m & 1) asm volatile("" ::: "memory");
                }
        }
#pragma unroll
        for (int ai = 0; ai < 2; ++ai)
#pragma unroll
            for (int bj = 0; bj < 2; ++bj)
#pragma unroll
                for (int m = 0; m < 4; ++m)
#pragma unroll
                    for (int n = 0; n < 2; ++n) acc[ai][bj][m][n] *= 0.f;
    }
};
struct EpiZ1 {
    typedef PreNone Pre;
    __device__ __forceinline__ void pre_load(const Unit& u, int wr, int fr, int fq, Pre& P) const {  }
    static constexpr bool PERM = true, KEEP = false;
    const float* ssq; bf16_t* zp;
    __device__ __forceinline__ void operator()(f32x4 (&acc)[2][2][4][2], const Unit& u, int wr, int wc, int fr, int fq, const Pre& pre) const {
        const int gg = u.pm >> 1, ri = u.pm & 1, b = u.pn >> 4, s0 = (u.pn & 15) * 256;
        float rs[2][8];
#pragma unroll
        for (int bj = 0; bj < 2; ++bj)
#pragma unroll
            for (int i = 0; i < 8; ++i) { const int tok = u.pn * 256 + bj * 128 + wc * 32 + fq * 8 + i;
                float s = ssq[(size_t)tok * 16 + fr]; s += __shfl_xor(s, 1); s += __shfl_xor(s, 2); s += __shfl_xor(s, 4); s += __shfl_xor(s, 8);
                rs[bj][i] = rsqrtf(s * (1.f / 1024.f) + 1e-6f); }
#pragma unroll
        for (int ai = 0; ai < 2; ++ai)
#pragma unroll
            for (int m = 0; m < 4; ++m) {
                const int l = ai * 128 + wr * 64 + m * 16 + fr;
                bf16_t* rowp = zp + ((size_t)((b * 4 + gg) * 256 + l)) * 8192 + ri * 4096 + s0;
#pragma unroll
                for (int bj = 0; bj < 2; ++bj) { const f32x4 v0 = acc[ai][bj][m][0], v1 = acc[ai][bj][m][1];
                    u32x4 w; w.x = cvt_pk_bf16(v0[0] * rs[bj][0], v0[1] * rs[bj][1]); w.y = cvt_pk_bf16(v0[2] * rs[bj][2], v0[3] * rs[bj][3]);
                    w.z = cvt_pk_bf16(v1[0] * rs[bj][4], v1[1] * rs[bj][5]); w.w = cvt_pk_bf16(v1[2] * rs[bj][6], v1[3] * rs[bj][7]);
                    *(u32x4*)(rowp + bj * 128 + wc * 32 + fq * 8) = w; }
            }
    }
};

__device__ __forceinline__ void conv_wt(const float* __restrict__ W, int K, int N, bf16_t* __restrict__ dst, const float* __restrict__ gain, int mode, int cs_lo, int cs_hi, float cs, size_t gtid, size_t gstride) {
    const size_t total = (size_t)(K / 8) * N;
#pragma unroll 4
    for (size_t idx = gtid; idx < total; idx += gstride) {
        const int n = (int)(idx % N), k0 = (int)(idx / N) * 8; float v[8];
        const float sc = (n >= cs_lo && n < cs_hi) ? cs : 1.f;
#pragma unroll
        for (int j = 0; j < 8; ++j) { v[j] = W[(size_t)(k0 + j) * N + n] * sc; if (gain) v[j] *= gain[k0 + j]; }
        const int drow = mode == 0 ? n : ((n >> 7) * 256 + (mode == 2 ? 128 : 0) + (n & 127));
        u32x4 w; w.x = cvt_pk_bf16(v[0], v[1]); w.y = cvt_pk_bf16(v[2], v[3]); w.z = cvt_pk_bf16(v[4], v[5]); w.w = cvt_pk_bf16(v[6], v[7]);
        *(u32x4*)(dst + (size_t)drow * K + k0) = w;
    }
}

__device__ __forceinline__ void phase_prep(const Params& p) {
    const size_t gtid = (size_t)blockIdx.x * blockDim.x + threadIdx.x, gstride = (size_t)gridDim.x * blockDim.x;
    bf16_t* wb = (bf16_t*)(p.ws + WS_W);
    for (int j = 0; j < 2; ++j) {
        conv_wt(p.ret_w_in + (size_t)j * 1024 * 6144, 1024, 6144, wb + W_IN + (size_t)j * 6291456, p.norm_mix + (size_t)(2 * j) * 1024, 0, 1024, 2048, 0.0625f, gtid, gstride);
        conv_wt(p.ret_w_out + (size_t)j * 2048 * 1024, 2048, 1024, wb + W_OUT + (size_t)j * 2097152, nullptr, 0, 0, 0, 1.f, gtid, gstride);
        conv_wt(p.fno_w + (size_t)j * 1048576, 1024, 1024, wb + W_FNO + (size_t)j * 1048576, nullptr, 0, 0, 0, 1.f, gtid, gstride);
        const float* gain = p.norm_mix + (size_t)(2 * j + 1) * 1024;
        for (size_t idx = gtid; idx < 524288; idx += gstride) { const int c = (int)(idx & 255), np = (int)((idx >> 8) & 511), g = (int)(idx >> 17);
            const float ph = (float)((c * (np & 255)) & 255) * (1.f / 256.f);
            const float v = (np < 256 ? __builtin_amdgcn_cosf(ph) : -__builtin_amdgcn_sinf(ph)) * gain[g * 256 + c] * (1.f / 1024.f);
            wb[W_DFT + (size_t)j * 524288 + idx] = f2bf(v); }
    }
    for (int i = 0; i < 4; ++i) {
        conv_wt(p.w_gate + (size_t)i * 1024 * DFF, 1024, DFF, wb + W_GU + (size_t)i * 5767168, p.norm_ffn + (size_t)i * 1024, 1, 0, 0, 1.f, gtid, gstride);
        conv_wt(p.w_up + (size_t)i * 1024 * DFF, 1024, DFF, wb + W_GU + (size_t)i * 5767168, p.norm_ffn + (size_t)i * 1024, 2, 0, 0, 1.f, gtid, gstride);
        conv_wt(p.w_down + (size_t)i * DFF * 1024, DFF, 1024, wb + W_DN + (size_t)i * 2883584, nullptr, 0, 0, 0, 1.f, gtid, gstride);
        conv_wt(p.ple_wg + (size_t)i * 1048576, 1024, 1024, wb + W_PG + (size_t)i * 1048576, p.norm_ple + (size_t)i * 1024, 0, 0, 0, 1.f, gtid, gstride);
        conv_wt(p.ple_wp + (size_t)i * 262144, 256, 1024, wb + W_PP + (size_t)i * 262144, nullptr, 0, 0, 0, 1.f, gtid, gstride);
    }
    unsigned* __restrict__ rope = (unsigned*)(p.ws + WS_ROPE); const int* __restrict__ posp = p.pos;
#pragma unroll 4
    for (size_t idx = gtid; idx < (size_t)T * 128; idx += gstride) {
        const int d = (int)(idx & 127); const int tok = (int)(idx >> 7);
        const float freq = 1.0f / exp2f(13.287712379549449f * ((float)d * (1.0f / 127.0f)));
        const float ang = (float)posp[tok] * freq;
        const double rev = (double)ang * 0.15915494309189535; const float fr = (float)(rev - __builtin_rint(rev));
        h16x2 cs; cs.x = (_Float16)__builtin_amdgcn_cosf(fr); cs.y = (_Float16)__builtin_amdgcn_sinf(fr);
        rope[idx] = __builtin_bit_cast(unsigned, cs);
    }
    const int lane = threadIdx.x & 63; const size_t gw = gtid >> 6, nw = gstride >> 6;
    bf16_t* xb = (bf16_t*)p.out; float* ssq = (float*)(p.ws + WS_SSQ);
#pragma unroll 2
    for (size_t row = gw; row < (size_t)T; row += nw) {
        float s = 0.f;
#pragma unroll
        for (int j = 0; j < 4; ++j) { const size_t off = row * 1024 + j * 256 + lane * 4; const f32x4 v = *(const f32x4*)(p.x + off); s += sum4(v * v);
            u32x2 w; w.x = cvt_pk_bf16(v[0], v[1]); w.y = cvt_pk_bf16(v[2], v[3]); *(u32x2*)(xb + off) = w; }
#pragma unroll
        for (int o = 1; o < 64; o <<= 1) s += __shfl_xor(s, o);
        if (lane < 16) ssq[row * 16 + lane] = lane == 0 ? s : 0.f;
    }
}

constexpr size_t WS_BAR = 243 * MiB;
#define XB_TMO      128
#define XB_XCNT(j)  (256  + 64 * (j))
#define XB_XSUB(j)  (1280 + 64 * (j))
#define XB_XGEN(j)  (2304 + 64 * (j))
#define XB_TOP      3328
#define XB_TOPGEN   3392
#define XCD_BAR_WORDS 3456
#define XB_SPIN_CAP (1u << 20)
__device__ __forceinline__ unsigned xb_ld(unsigned* p)              { return __hip_atomic_load(p, __ATOMIC_RELAXED, __HIP_MEMORY_SCOPE_AGENT); }
__device__ __forceinline__ unsigned xb_add(unsigned* p, unsigned v) { return __hip_atomic_fetch_add(p, v, __ATOMIC_RELAXED, __HIP_MEMORY_SCOPE_AGENT); }
__device__ __forceinline__ unsigned xb_xcc_id() { return (unsigned)__builtin_amdgcn_s_getreg((3 << 11) | 20) & 0xFu; }
#define XB_SPIN(cond, bar) do { unsigned _sp = 0; while (cond) { __builtin_amdgcn_s_sleep(1); \
    if ((++_sp & 255u) == 0u) { if (xb_ld(&(bar)[XB_TMO])) break; if (_sp > XB_SPIN_CAP) { atomicAdd(&(bar)[XB_TMO], 1u); break; } } } } while (0)
__device__ __forceinline__ void xcd_census(unsigned* bar, unsigned x, unsigned& nloc, unsigned& nx) {
    const unsigned G = gridDim.x; unsigned sum, cnt, mine, sp = 0u;
    for (;;) {
        sum = 0u; cnt = 0u; mine = 0u;
#pragma unroll
        for (unsigned j = 0; j < 16; ++j) { const unsigned c = xb_ld(&bar[XB_XCNT(j)]); sum += c; cnt += (c > 0u) ? 1u : 0u; mine = (j == x) ? c : mine; }
        if (sum == G) break;
        __builtin_amdgcn_s_sleep(1);
        if ((++sp & 255u) == 0u) { if (xb_ld(&bar[XB_TMO])) break; if (sp > XB_SPIN_CAP) { atomicAdd(&bar[XB_TMO], 1u); break; } }
    }
    nloc = mine > 0u ? mine : 1u; nx = cnt > 0u ? cnt : 1u;
}
__device__ __forceinline__ void grid_bar(unsigned* bar) {
    asm volatile("s_waitcnt vmcnt(0)" ::: "memory");
    __syncthreads();
    if (threadIdx.x == 0) {
        __builtin_amdgcn_s_waitcnt(0);
        const unsigned x = xb_xcc_id();
        unsigned* mine = bar + XCD_BAR_WORDS + 2 * blockIdx.x;
        unsigned nloc = mine[0], nx = mine[1];
        if (nloc == 0u) { xcd_census(bar, x, nloc, nx); mine[0] = nloc; mine[1] = nx; }
        const unsigned old = xb_add(&bar[XB_XSUB(x)], 1u);
        const unsigned gen = old / nloc;
        if (old + 1u == (gen + 1u) * nloc) {
            __builtin_amdgcn_fence(__ATOMIC_RELEASE, "agent");
            asm volatile("s_waitcnt vmcnt(0)" ::: "memory");
            const unsigned og = xb_add(&bar[XB_TOP], 1u);
            const unsigned tg = og / nx;
            if (og + 1u == (tg + 1u) * nx) xb_add(&bar[XB_TOPGEN], 1u);
            else XB_SPIN(xb_ld(&bar[XB_TOPGEN]) == tg, bar);
            __builtin_amdgcn_fence(__ATOMIC_ACQUIRE, "agent");
            xb_add(&bar[XB_XGEN(x)], 1u);
            asm volatile("s_waitcnt vmcnt(0)" ::: "memory");
        } else {
            XB_SPIN(xb_ld(&bar[XB_XGEN(x)]) == gen, bar);
            __builtin_amdgcn_fence(__ATOMIC_ACQUIRE, "agent");
            asm volatile("s_waitcnt vmcnt(0)" ::: "memory");
        }
    }
    __syncthreads();
}

__global__ void __launch_bounds__(512, 2) fwd_kernel(const Params p) {
    extern __shared__ __attribute__((aligned(16))) unsigned char shm[];
    LAS unsigned char* lds = (LAS unsigned char*)shm;
#define gtid ((size_t)blockIdx.x * 512 + (size_t)tidl)
#define gstride ((size_t)gridDim.x * 512)
#define scr (ws + WS_SCR)
#define xb (xsel ? (bf16_t*)outl : (bf16_t*)(ws + WS_XB))
#define xb_oth (xsel ? (bf16_t*)(ws + WS_XB) : (bf16_t*)outl)
#define wb ((bf16_t*)(ws + WS_W))
#define ssq0 ((float*)(ws + WS_SSQ))
#define ssq1 ((float*)(ws + WS_SSQ) + (size_t)T * 16)
#define gst ((float*)(ws + WS_GST))
#define q_b ((bf16_t*)(scr + R_Q))
#define k_b ((bf16_t*)(scr + R_K))
#define ktf_b ((bf16_t*)(scr + R_KTF))
#define ktb_b ((bf16_t*)(scr + R_KTB))
#define vtc_b ((bf16_t*)(scr + R_VTC))
#define P_b ((bf16_t*)(scr + R_P))
#define rf_b ((bf16_t*)(scr + R_RF))
#define rb_b ((bf16_t*)(scr + R_RB))
#define o_b ((bf16_t*)(scr + R_O))
#define zp_b ((bf16_t*)(scr + Z_ZP))
#define F_b ((bf16_t*)(scr + Z_F))
#define dseq_b ((bf16_t*)(scr + Z_D))
#define H_b ((bf16_t*)(scr + F_H))
#define pp_b ((bf16_t*)(scr + F_PP))
#define pb_b ((bf16_t*)(scr + F_PB))
    int ph = 0, nrm = 0, xsel = 1;
#if COOP
    cg::grid_group grid = cg::this_grid();
    if (threadIdx.x == 0) (void)xb_add(&((unsigned*)(p.ws + WS_BAR))[XB_XCNT(xb_xcc_id())], 1u);
#define PH_BEGIN if (ph >= p.ph_lo && ph < p.ph_hi) { size_t zofs = 0; asm volatile("" : "+s"(zofs)); unsigned char* ws = p.ws + zofs; int tidl = threadIdx.x; asm volatile("" : "+v"(tidl)); float* outl = p.out + zofs;
#define PH_END if (ph + 1 < p.ph_hi) { if (p.ph_hi < 0) grid.sync(); else grid_bar((unsigned*)(p.ws + WS_BAR)); } } ++ph;
#else
#define PH_BEGIN if (ph >= p.ph_lo && ph < p.ph_hi) { size_t zofs = 0; asm volatile("" : "+s"(zofs)); unsigned char* ws = p.ws + zofs; int tidl = threadIdx.x; asm volatile("" : "+v"(tidl)); float* outl = p.out + zofs;
#define PH_END } ++ph;
#endif
#define SSQ_CUR ((nrm & 1) ? ssq1 : ssq0)
#define SSQ_NXT ((nrm & 1) ? ssq0 : ssq1)

    PH_BEGIN if (PHSEL(0)) phase_prep(p); PH_END

    for (int layer = 0; layer < 4; ++layer) {
        const int jj = layer >> 1;
        if ((layer & 1) == 0) {
#define decay (p.ret_decay + (size_t)jj * 8)
            for (int hf = 0; hf < 2; ++hf) {
                const int tok0 = hf * TH;
                PH_BEGIN if (PHSEL(1)) {
                    TileSched S; S.init(xb + (size_t)tok0 * 1024, wb + W_IN + (size_t)jj * 6291456, 1024, 1024, 128, 16);
                    EpiR1 E{SSQ_CUR, (const unsigned*)(ws + WS_ROPE), decay, q_b, k_b, ktf_b, ktb_b, vtc_b, tok0, lds + STAGE_BYTES};
                    gemm_phase(lds, S, E, 1024, 1024, 16);
                } PH_END
                PH_BEGIN if (PHSEL(2)) {
                    const int c = blockIdx.x;
#if !defined(SUB) || SUB == 0
                    { const bool act = c < 128; const int item = act ? c : 0, bh = item >> 2, dir = (item >> 1) & 1, half = item & 1, h = bh & 3;
                      bf16_t* rt = (dir ? rb_b : rf_b) + (size_t)bh * 16 * 131072 + (size_t)half * 65536;
                      if (act) { bf16_t* z = rt + (size_t)(dir ? 15 : 0) * 131072; unsigned zz = 0u; asm volatile("" : "+v"(zz)); for (int i = tidl; i < 8192; i += 512) *(u32x4*)(z + (size_t)i * 8) = (u32x4){zz, zz, zz, zz}; }
                      ScanSched S{(const char*)(vtc_b + (size_t)bh * 16 * 131072 + (size_t)half * 65536), (const char*)((dir ? ktb_b : ktf_b) + (size_t)bh * 16 * 65536), dir, act};
                      EpiScan E{rt, dir, decay + dir * 4 + h};
                      gemm_phase(lds, S, E, 256, 256, 4); }
#endif
#if !defined(SUB) || SUB == 1
                    { ScoreSched S{(const char*)q_b, (const char*)k_b, c >= 128 ? c - 128 : -1, (int)gridDim.x - 128};
                      EpiScore E{decay, P_b};
                      gemm_phase(lds, S, E, 256, 256, 4); }
#endif
                } PH_END
                PH_BEGIN if (PHSEL(3)) {
                    OutSched S{(const char*)scr, (int)gridDim.x, (int)blockIdx.x};
                    EpiOut E{decay, o_b, gst};
                    gemm_phase(lds, S, E, 256, 256, 4);
                } PH_END
                PH_BEGIN if (PHSEL(4)) {
                    TileSched S; S.init(xb + (size_t)tok0 * 1024, wb + W_IN + (size_t)jj * 6291456 + (size_t)4096 * 1024, 1024, 1024, 128, 8);
                    EpiGate E{SSQ_CUR, gst, p.ret_gn + (size_t)jj * 2048, o_b, tok0};
                    gemm_phase(lds, S, E, 1024, 1024, 16);
                } PH_END
                PH_BEGIN if (PHSEL(5)) {
                    TileSched S; S.init(o_b, wb + W_OUT + (size_t)jj * 2097152, 2048, 2048, 128, 4);
                    EpiResid<false> E{xb, xb, SSQ_NXT, nullptr, nullptr, tok0, nullptr};
                    gemm_phase(lds, S, E, 2048, 2048, 32);
                } PH_END
            }
            ++nrm;
        } else {
            PH_BEGIN if (PHSEL(6)) {
                for (size_t idx = gtid; idx < (size_t)2048 * 512; idx += gstride) { const int kk = (int)(idx >> 9), c8 = (int)(idx & 511) * 8; const int s0 = c8 & 2047; float v[8];
#pragma unroll
                    for (int i = 0; i < 8; ++i) { const float phs = (float)((kk * (s0 + i)) & 4095) * (1.f / 4096.f); v[i] = c8 < 2048 ? __builtin_amdgcn_cosf(phs) : __builtin_amdgcn_sinf(phs); }
                    u32x4 w; w.x = cvt_pk_bf16(v[0], v[1]); w.y = cvt_pk_bf16(v[2], v[3]); w.z = cvt_pk_bf16(v[4], v[5]); w.w = cvt_pk_bf16(v[6], v[7]);
                    *(u32x4*)(dseq_b + (size_t)kk * 4096 + c8) = w; }
                Z1Sched S{(const char*)(wb + W_DFT + (size_t)jj * 524288), (const char*)xb, (int)gridDim.x, (int)blockIdx.x};
                EpiZ1 E{SSQ_CUR, zp_b};
                gemm_phase(lds, S, E, 256, 1024, 4);
            } PH_END
            PH_BEGIN if (PHSEL(13)) {
                bf16_t* zf = (bf16_t*)(scr + Z_ZF); bf16_t* nyq = (bf16_t*)(scr + Z_NY);
#pragma unroll 2
                for (size_t idx = gtid; idx < (size_t)16384 * 256; idx += gstride) { const size_t col = idx >> 8; const int a = (int)(idx & 255) * 8;
                    const bf16_t* zr = zp_b + col * 8192; const bf16_t* zi = zr + 4096;
                    const u32x4 r0 = *(const u32x4*)(zr + a), r1 = *(const u32x4*)(zr + 4088 - a), r2 = *(const u32x4*)(zr + (a ? 4096 - a : 0));
                    const u32x4 i0 = *(const u32x4*)(zi + a), i1 = *(const u32x4*)(zi + 4088 - a), i2 = *(const u32x4*)(zi + (a ? 4096 - a : 0));
                    float dr[8], di[8], mr[8], mi[8];
#pragma unroll
                    for (int j = 0; j < 4; ++j) { dr[2 * j] = bflo(r0[j]); dr[2 * j + 1] = bfhi(r0[j]); di[2 * j] = bflo(i0[j]); di[2 * j + 1] = bfhi(i0[j]); }
#pragma unroll
                    for (int e = 1; e < 8; ++e) { mr[8 - e] = (e & 1) ? bfhi(r1[e >> 1]) : bflo(r1[e >> 1]); mi[8 - e] = (e & 1) ? bfhi(i1[e >> 1]) : bflo(i1[e >> 1]); }
                    mr[0] = a ? bflo(r2[0]) : 0.f; mi[0] = a ? bflo(i2[0]) : 0.f;
                    float er[8], oi[8];
#pragma unroll
                    for (int i = 0; i < 8; ++i) { er[i] = dr[i] + mr[i]; oi[i] = di[i] - mi[i]; }
                    if (a == 0) oi[0] = 0.f;
                    u32x4 w; w.x = cvt_pk_bf16(er[0], er[1]); w.y = cvt_pk_bf16(er[2], er[3]); w.z = cvt_pk_bf16(er[4], er[5]); w.w = cvt_pk_bf16(er[6], er[7]);
                    *(u32x4*)(zf + col * 4096 + a) = w;
                    u32x4 x; x.x = cvt_pk_bf16(oi[0], oi[1]); x.y = cvt_pk_bf16(oi[2], oi[3]); x.z = cvt_pk_bf16(oi[4], oi[5]); x.w = cvt_pk_bf16(oi[6], oi[7]);
                    *(u32x4*)(zf + col * 4096 + 2048 + a) = x;
                    if (a == 0) nyq[col] = zr[2048]; }
            } PH_END
            PH_BEGIN if (PHSEL(7)) {
                Z2Sched S{(const char*)dseq_b, (const char*)(scr + Z_ZF), (int)gridDim.x, (int)blockIdx.x};
                EpiZ2 E{F_b, (float*)(scr + Z_ST) + (size_t)blockIdx.x * 131072, (const bf16_t*)(scr + Z_NY)};
                gemm_phase(lds, S, E, 4096, 4096, 32);
                { const int lane = tidl & 63; const size_t gw = gtid >> 6, nw = gstride >> 6;
                  for (size_t col = gw; col < 16384; col += nw) {
                      float a = 0.f;
#pragma unroll
                      for (int i = 0; i < 8; ++i) { const u32x4 v = *(const u32x4*)(zp_b + col * 8192 + (size_t)i * 512 + lane * 8);
                          a += (bflo(v.x) - bfhi(v.x)) + (bflo(v.y) - bfhi(v.y)) + (bflo(v.z) - bfhi(v.z)) + (bflo(v.w) - bfhi(v.w)); }
#pragma unroll
                      for (int o = 1; o < 64; o <<= 1) a += __shfl_xor(a, o);
                      if (lane == 0) F_b[((size_t)(col >> 10) * 4096 + 2048) * 1024 + (col & 1023)] = f2bf(a); } }
            } PH_END
            PH_BEGIN if (PHSEL(8)) {
                TileSched S; S.init(F_b, wb + W_FNO + (size_t)jj * 1048576, 1024, 1024, 256, 4);
                EpiResid<false> E{xb, xb, SSQ_NXT, nullptr, nullptr, 0, nullptr};
                gemm_phase(lds, S, E, 1024, 1024, 16);
            } PH_END
            ++nrm;
        }
        PH_BEGIN if (PHSEL(9)) {
            TileSched S; S.init(xb, wb + W_GU + (size_t)layer * 5767168, 1024, 1024, 256, 22);
            EpiF1 E{SSQ_CUR, H_b};
            gemm_phase(lds, S, E, 1024, 1024, 16);
            const float* pl = p.p + (size_t)layer * T * 256;
#pragma unroll 4
            for (size_t idx = gtid; idx < (size_t)T * 32; idx += gstride) { const f32x4 a = *(const f32x4*)(pl + idx * 8), b = *(const f32x4*)(pl + idx * 8 + 4);
                u32x4 w; w.x = cvt_pk_bf16(a[0], a[1]); w.y = cvt_pk_bf16(a[2], a[3]); w.z = cvt_pk_bf16(b[0], b[1]); w.w = cvt_pk_bf16(b[2], b[3]); *(u32x4*)(pb_b + idx * 8) = w; }
        } PH_END
        PH_BEGIN if (PHSEL(10)) {
            { TileSched S; S.init(H_b, wb + W_DN + (size_t)layer * 2883584, DFF, DFF, 256, 4);
              EpiResid<false> E{xb, xb, SSQ_NXT, nullptr, nullptr, 0, nullptr};
              gemm_phase(lds, S, E, DFF, DFF, 44); }
            { TileSched S; S.init(pb_b, wb + W_PP + (size_t)layer * 262144, 256, 256, 256, 4);
              EpiPlain<false> E{pp_b, 1024};
              gemm_phase(lds, S, E, 256, 256, 4); }
        } PH_END
        ++nrm;
        PH_BEGIN if (PHSEL(11)) {
            TileSched S; S.init(xb, wb + W_PG + (size_t)layer * 1048576, 1024, 1024, 256, 4);
            EpiResid<true> E{xb, xb_oth, SSQ_NXT, SSQ_CUR, pp_b, 0, layer == 3 ? outl : nullptr};
            gemm_phase(lds, S, E, 1024, 1024, 16);
        } PH_END
        ++nrm; xsel ^= 1;
    }
    PH_BEGIN if (PHSEL(12)) {
        const int lane = tidl & 63; const size_t gw = gtid >> 6, nw = gstride >> 6; const float* ssq = SSQ_CUR;
        for (size_t row = gw; row < (size_t)T; row += nw) {
            float s = lane < 16 ? ssq[row * 16 + lane] : 0.f;
#pragma unroll
            for (int o = 1; o < 16; o <<= 1) s += __shfl_xor(s, o);
            s = __shfl(s, 0);
            const float rs = rsqrtf(s * (1.f / 1024.f) + 1e-6f);
#pragma unroll
            for (int j = 0; j < 4; ++j) { const size_t off = row * 1024 + j * 256 + lane * 4; const f32x4 g = *(const f32x4*)(p.final_norm + j * 256 + lane * 4);
                f32x4 v = *(const f32x4*)(outl + off); v = v * rs * g; *(f32x4*)(outl + off) = v; }
        }
    } PH_END
}

constexpr int LDS_TOTAL = STAGE_BYTES + 32768;
constexpr int N_PHASES = 1 + 2 * (10 + 3) + 2 * (4 + 3) + 1;

extern "C" void kernel_launch(void* const* d_in, const int* in_sizes, int n_in, void* d_out, int out_size, void* d_ws, size_t ws_size, hipStream_t stream) {
    static int ready = 0;
    if (!ready) {
        if (hipFuncSetAttribute((const void*)fwd_kernel, hipFuncAttributeMaxDynamicSharedMemorySize, LDS_TOTAL) != hipSuccess) { fprintf(stderr, "hipFuncSetAttribute failed\n"); ready = -1; return; }
        if (ws_size < 1000 * MiB) { fprintf(stderr, "workspace too small: %zu\n", ws_size); ready = -1; return; }
        ready = 1;
    }
    if (ready < 0) return;
    Params p{};
    p.x = (const float*)d_in[0]; p.p = (const float*)d_in[1]; p.pos = (const int*)d_in[2]; p.norm_mix = (const float*)d_in[3]; p.ret_w_in = (const float*)d_in[4]; p.ret_w_out = (const float*)d_in[5];
    p.ret_gn = (const float*)d_in[6]; p.ret_decay = (const float*)d_in[7]; p.fno_w = (const float*)d_in[8]; p.norm_ffn = (const float*)d_in[9]; p.w_gate = (const float*)d_in[10]; p.w_up = (const float*)d_in[11];
    p.w_down = (const float*)d_in[12]; p.norm_ple = (const float*)d_in[13]; p.ple_wg = (const float*)d_in[14]; p.ple_wp = (const float*)d_in[15]; p.final_norm = (const float*)d_in[16];
    p.out = (float*)d_out; p.ws = (unsigned char*)d_ws;
#if COOP
    p.ph_lo = 0; p.ph_hi = N_PHASES;
    hipMemsetAsync((unsigned char*)d_ws + WS_BAR, 0, (XCD_BAR_WORDS + 2 * 256) * 4, stream);
    void* args[] = {&p};
    hipError_t e = hipLaunchCooperativeKernel((const void*)fwd_kernel, dim3(256), dim3(512), args, LDS_TOTAL, stream);
    if (e != hipSuccess) fprintf(stderr, "cooperative launch failed: %s\n", hipGetErrorString(e));
#else
    for (int ph = 0; ph < N_PHASES; ++ph) { p.ph_lo = ph; p.ph_hi = ph + 1; hipLaunchKernelGGL(fwd_kernel, dim3(256), dim3(512), LDS_TOTAL, stream, p); }
#endif
}
```

```cpp
#include <hip/hip_runtime.h>
#include <hip/hip_cooperative_groups.h>
#include <cstdio>
namespace cg = cooperative_groups;

#define LAS __attribute__((address_space(3)))
typedef unsigned short bf16_t;
typedef short bf16x8 __attribute__((ext_vector_type(8)));
typedef float f32x4 __attribute__((ext_vector_type(4)));
typedef float f32x2 __attribute__((ext_vector_type(2)));
typedef unsigned u32x4 __attribute__((ext_vector_type(4)));
typedef unsigned u32x2 __attribute__((ext_vector_type(2)));
typedef _Float16 h16x2 __attribute__((ext_vector_type(2)));

#ifndef COOP
#define COOP 1
#endif
#ifndef ONLY
#define ONLY -1
#endif
#define EX2(x) __builtin_amdgcn_exp2f(x)
#ifndef EXPDUP
#define EXPDUP -1
#endif
#define PHSEL(k) (ONLY < 0 || ONLY == (k))) for (int rep_ = 0; rep_ < ((EXPDUP) == (k) ? 2 : 1); ++rep_) if ((true)

constexpr int T = 65536, D = 1024, SEQ = 4096, DFF = 2816;
constexpr int TH = 32768;
constexpr size_t MiB = (size_t)1 << 20;
constexpr size_t WS_XB = 0;
constexpr size_t WS_W = 128 * MiB;
constexpr size_t WS_ROPE = 244 * MiB;
constexpr size_t WS_SSQ = 276 * MiB;
constexpr size_t WS_GST = 284 * MiB;
constexpr size_t WS_SCR = 292 * MiB;
constexpr size_t R_Q = 0, R_K = 64 * MiB, R_KTF = 128 * MiB, R_KTB = 192 * MiB, R_VTC = 256 * MiB, R_P = 384 * MiB, R_RF = 448 * MiB, R_RB = 576 * MiB;
constexpr size_t R_O = 64 * MiB;
constexpr size_t F_H = 0, F_PP = 352 * MiB, F_PB = 480 * MiB;
constexpr size_t Z_ZP = 0, Z_F = 256 * MiB, Z_D = 384 * MiB, Z_NY = 416 * MiB, Z_ST = 448 * MiB, Z_ZF = 576 * MiB;
constexpr size_t W_IN = 0;
constexpr size_t W_OUT = W_IN + 2 * 6291456;
constexpr size_t W_FNO = W_OUT + 2 * 2097152;
constexpr size_t W_DFT = W_FNO + 2 * 1048576;
constexpr size_t W_GU = W_DFT + 2 * 524288;
constexpr size_t W_DN = W_GU + 4 * 5767168;
constexpr size_t W_PG = W_DN + 4 * 2883584;
constexpr size_t W_PP = W_PG + 4 * 1048576;

struct Params {
    const float* x; const float* p; const int* pos; const float* norm_mix; const float* ret_w_in; const float* ret_w_out; const float* ret_gn; const float* ret_decay;
    const float* fno_w; const float* norm_ffn; const float* w_gate; const float* w_up; const float* w_down; const float* norm_ple; const float* ple_wg; const float* ple_wp; const float* final_norm;
    float* out; unsigned char* ws; int ph_lo, ph_hi;
};

__device__ __forceinline__ unsigned cvt_pk_bf16(float lo, float hi) { unsigned r; asm("v_cvt_pk_bf16_f32 %0, %1, %2" : "=v"(r) : "v"(lo), "v"(hi)); return r; }
__device__ __forceinline__ bf16_t f2bf(float f) { return (bf16_t)(cvt_pk_bf16(f, 0.f) & 0xffffu); }
__device__ __forceinline__ float bflo(unsigned w) { return __uint_as_float(w << 16); }
__device__ __forceinline__ float bfhi(unsigned w) { return __uint_as_float(w & 0xffff0000u); }
__device__ __forceinline__ float silu_f(float v) { return v * __builtin_amdgcn_rcpf(1.f + __expf(-v)); }
__device__ __forceinline__ float sigmoid_f(float v) { return __builtin_amdgcn_rcpf(1.f + __expf(-v)); }
__device__ __forceinline__ float lg2sig(float logit) { return -__log2f(1.f + __expf(-logit)); }
__device__ __forceinline__ float sum4(f32x4 v) { return (v[0] + v[1]) + (v[2] + v[3]); }
__device__ __forceinline__ float row_rstd(const float* ssq, int tok, int fq) {
    float s = sum4(*(const f32x4*)(ssq + (size_t)tok * 16 + fq * 4));
    s += __shfl_xor(s, 16); s += __shfl_xor(s, 32);
    return rsqrtf(s * (1.f / 1024.f) + 1e-6f);
}

struct PreNone { };
struct PreRs { float rs[8]; };
__device__ __forceinline__ void pre_rs(PreRs& P, const float* ssq, int row0, int wr, int fr, int fq) {
#pragma unroll
    for (int i = 0; i < 8; ++i) P.rs[i] = row_rstd(ssq, row0 + (i >> 2) * 128 + wr * 64 + (i & 3) * 16 + fr, fq);
#pragma unroll
    for (int i = 0; i < 8; ++i) asm volatile("" : "+v"(P.rs[i]));
}

constexpr int BM = 256, BK = 64, HALF = 128, HTB = HALF * BK * 2, STAGE_BYTES = 8 * HTB, NXCD = 8, WGM = 8;
__device__ __forceinline__ int lds_byte(int r, int c) { const int st = (r >> 4) * 2 + (c >> 5), rr = r & 15, cc = c & 31, ob = rr * 64 + cc * 2; return st * 1024 + (ob ^ (((ob >> 9) & 1) << 5)); }
__device__ __forceinline__ void stage_rc(int b, int& R, int& C) { const int st = b / 1024, sb = b % 1024, swz = sb ^ (((sb >> 9) & 1) << 5); R = (st >> 1) * 16 + swz / 64; C = (st & 1) * 32 + (swz % 64) / 2; }
__device__ __forceinline__ int perm32(int rho) { const int n = rho >> 4, i = rho & 15; return 8 * (i >> 2) + 4 * n + (i & 3); }
struct Unit { int pm, pn, z; };
__device__ __forceinline__ const char* uni(const char* p) { const unsigned long long v = (unsigned long long)p; const unsigned lo = __builtin_amdgcn_readfirstlane((unsigned)v), hi = __builtin_amdgcn_readfirstlane((unsigned)(v >> 32)); return (const char*)(((unsigned long long)hi << 32) | lo); }

template <class Epi, class Sched>
__device__ __forceinline__ void gemm_phase(LAS unsigned char* lds, const Sched& S, const Epi& E, const int lda, const int ldb, const int nt) {
    int tid = threadIdx.x; asm volatile("" : "+v"(tid));
    const int wid = __builtin_amdgcn_readfirstlane(tid >> 6), lane = tid & 63, wr = wid >> 2, wc = wid & 3, fr = lane & 15, fq = lane >> 4;
    unsigned voffA[2], voffB[2];
#pragma unroll
    for (int i = 0; i < 2; ++i) { int R, C; stage_rc(tid * 16 + i * 8192, R, C); const int Rb = Epi::PERM ? ((R & ~31) + perm32(R & 31)) : R;
        voffA[i] = (unsigned)(R * lda + C) * 2u; voffB[i] = (unsigned)(Rb * ldb + C) * 2u; }
    const size_t kstep = (size_t)(BK * 2);
    const size_t hstepA = (size_t)HALF * lda * 2, hstepB = (size_t)HALF * ldb * 2;
    const unsigned ldsbase = __builtin_amdgcn_readfirstlane((unsigned)(__UINTPTR_TYPE__)lds + (unsigned)wid * 1024u);
    const int aoff = lds_byte(wr * 64 + fr, fq * 8), boff = lds_byte(wc * 32 + fr, fq * 8);
#define G_SA(b, h) (((b) * 2 + (h)) * HTB)
#define G_SB(b, h) ((4 + (b) * 2 + (h)) * HTB)
#define G_STAGE(bufoff, gbase, voff) do { _Pragma("unroll") for (int _i = 0; _i < 2; ++_i) \
        asm volatile("s_mov_b32 m0, %0\n\ts_nop 0\n\tglobal_load_lds_dwordx4 %1, %2" :: "s"(ldsbase + (unsigned)((bufoff) + _i * 8192)), "v"((voff)[_i]), "s"((const char*)(gbase)) : "m0", "memory"); } while (0)
#define G_LDA(dst, b, h) do { _Pragma("unroll") for (int m = 0; m < 4; ++m) _Pragma("unroll") for (int k = 0; k < 2; ++k) dst[m][k] = *(const LAS bf16x8*)(lds + G_SA(b, h) + aoff + m * 2048 + k * 1024); } while (0)
#define G_LDB(dst, b, h) do { _Pragma("unroll") for (int n = 0; n < 2; ++n) _Pragma("unroll") for (int k = 0; k < 2; ++k) dst[n][k] = *(const LAS bf16x8*)(lds + G_SB(b, h) + boff + n * 2048 + k * 1024); } while (0)
#define G_MMA(ai, bj, At, Bt) do { __builtin_amdgcn_s_setprio(1); _Pragma("unroll") for (int m = 0; m < 4; ++m) _Pragma("unroll") for (int n = 0; n < 2; ++n) _Pragma("unroll") for (int k = 0; k < 2; ++k) \
        acc[ai][bj][m][n] = __builtin_amdgcn_mfma_f32_16x16x32_bf16(Bt[n][k], At[m][k], acc[ai][bj][m][n], 0, 0, 0); __builtin_amdgcn_s_setprio(0); } while (0)
#define G_WAIT_V(n) asm volatile("s_waitcnt vmcnt(" #n ")" ::: "memory")
#define G_WAIT_L(n) asm volatile("s_waitcnt lgkmcnt(" #n ")" ::: "memory")
#define G_BAR __builtin_amdgcn_s_barrier()
#define G_SCHED __builtin_amdgcn_sched_barrier(0)
    Unit cur, nxt; int ui = 0;
    if (!S.next(0, cur)) return;
    f32x4 acc[2][2][4][2];
#pragma unroll
    for (int a = 0; a < 2; ++a)
#pragma unroll
        for (int b = 0; b < 2; ++b)
#pragma unroll
            for (int m = 0; m < 4; ++m)
#pragma unroll
                for (int n = 0; n < 2; ++n) acc[a][b][m][n] = (f32x4){0.f, 0.f, 0.f, 0.f};
    bf16x8 At[4][2], B0[2][2], B1[2][2];
    const char* cA; const char* cB; S.ptrs(cur, cA, cB); cA = uni(cA); cB = uni(cB);
    typename Epi::Pre pre; E.pre_load(cur, wr, fr, fq, pre);
    G_STAGE(G_SB(0, 0), cB, voffB); G_STAGE(G_SA(0, 0), cA, voffA); G_STAGE(G_SB(0, 1), uni(cB + hstepB), voffB); G_STAGE(G_SA(0, 1), uni(cA + hstepA), voffA);
    if (wr == 1) G_BAR;
    G_WAIT_V(4); G_BAR;
    G_STAGE(G_SB(1, 0), uni(cB + kstep), voffB); G_STAGE(G_SA(1, 0), uni(cA + kstep), voffA); G_STAGE(G_SB(1, 1), uni(cB + hstepB + kstep), voffB);
    G_WAIT_V(6); G_BAR;
    for (;;) {
        const bool has_next = S.next(ui + 1, nxt);
        const char* nA = cA; const char* nB = cB; if (has_next) { S.ptrs(nxt, nA, nB); nA = uni(nA); nB = uni(nB); }
        for (int t = 0; t < nt; t += 2) {
            const bool last = (t == nt - 2);
            const char* a1 = uni(cA + (size_t)(t + 1) * kstep);
            const char* a2 = uni(last ? nA : cA + (size_t)(t + 2) * kstep); const char* b2 = uni(last ? nB : cB + (size_t)(t + 2) * kstep);
            const char* a3 = uni(a2 + kstep); const char* b3 = uni(b2 + kstep);
            const char* a1h = uni(a1 + hstepA); const char* a2h = uni(a2 + hstepA); const char* b2h = uni(b2 + hstepB); const char* b3h = uni(b3 + hstepB);
            G_LDB(B0, 0, 0); G_SCHED; G_LDA(At, 0, 0); G_STAGE(G_SA(1, 1), a1h, voffA);
            G_WAIT_L(8); G_BAR; G_WAIT_L(0); G_MMA(0, 0, At, B0); G_BAR; G_SCHED;
            G_LDB(B1, 0, 1); G_STAGE(G_SB(0, 0), b2, voffB);
            G_BAR; G_WAIT_L(0); G_MMA(0, 1, At, B1); G_BAR;
            G_LDA(At, 0, 1); G_STAGE(G_SA(0, 0), a2, voffA);
            G_BAR; G_WAIT_L(0); G_MMA(1, 0, At, B0); G_BAR; G_SCHED;
            G_STAGE(G_SB(0, 1), b2h, voffB);
            G_WAIT_V(6); G_BAR; G_MMA(1, 1, At, B1); G_BAR;
            G_LDB(B0, 1, 0); G_SCHED; G_LDA(At, 1, 0); G_STAGE(G_SA(0, 1), a2h, voffA);
            G_WAIT_L(8); G_BAR; G_WAIT_L(0); G_MMA(0, 0, At, B0); G_BAR; G_SCHED;
            G_LDB(B1, 1, 1); G_STAGE(G_SB(1, 0), b3, voffB);
            G_BAR; G_WAIT_L(0); G_MMA(0, 1, At, B1); G_BAR;
            G_LDA(At, 1, 1); G_STAGE(G_SA(1, 0), a3, voffA);
            G_BAR; G_WAIT_L(0); G_MMA(1, 0, At, B0); G_BAR; G_SCHED;
            G_STAGE(G_SB(1, 1), b3h, voffB);
            G_WAIT_V(6); G_BAR; G_MMA(1, 1, At, B1); G_BAR;
        }
        { int fr_o = fr, fq_o = fq; asm volatile("" : "+v"(fr_o), "+v"(fq_o)); E(acc, cur, wr, wc, fr_o, fq_o, pre); }
        if (!has_next) break;
        if (!Epi::KEEP) {
#pragma unroll
            for (int a = 0; a < 2; ++a)
#pragma unroll
                for (int b = 0; b < 2; ++b)
#pragma unroll
                    for (int m = 0; m < 4; ++m)
#pragma unroll
                        for (int n = 0; n < 2; ++n) acc[a][b][m][n] = (f32x4){0.f, 0.f, 0.f, 0.f};
        }
        cur = nxt; cA = nA; cB = nB; ++ui;
        E.pre_load(cur, wr, fr, fq, pre);
    }
    G_WAIT_V(0);
    if (wr == 0) G_BAR;
    G_BAR;
#undef G_SA
#undef G_SB
#undef G_STAGE
#undef G_LDA
#undef G_LDB
#undef G_MMA
#undef G_WAIT_V
#undef G_WAIT_L
#undef G_BAR
#undef G_SCHED
}

struct TileSched {
    const char* A; const char* B; size_t sA, sB; int nM, nN, nwg, G, c;
    __device__ __forceinline__ void init(const void* A_, const void* B_, int lda, int ldb, int nM_, int nN_) {
        A = (const char*)A_; B = (const char*)B_; sA = (size_t)BM * lda * 2; sB = (size_t)BM * ldb * 2; nM = nM_; nN = nN_; nwg = nM * nN; G = gridDim.x; c = blockIdx.x; }
    __device__ __forceinline__ bool next(int i, Unit& u) const {
        const long L = (long)i * G + c; if (L >= nwg) return false;
        int wgid = (int)L; { const int q = nwg / NXCD, r = nwg % NXCD, xcd = wgid % NXCD, off = wgid / NXCD; wgid = (xcd < r ? xcd * (q + 1) : r * (q + 1) + (xcd - r) * q) + off; }
        const int nig = WGM * nN, gid = wgid / nig, fm = gid * WGM, gsz = (nM - fm) < WGM ? (nM - fm) : WGM;
        u.pm = fm + ((wgid % nig) % gsz); u.pn = (wgid % nig) / gsz; u.z = 0; return true;
    }
    __device__ __forceinline__ void ptrs(const Unit& u, const char*& a, const char*& b) const { a = A + (size_t)u.pm * sA; b = B + (size_t)u.pn * sB; }
};
struct Z1Sched {
    const char* W; const char* X; int G, c;
    __device__ __forceinline__ bool next(int i, Unit& u) const { if (i * G + c >= 2048) return false; const int x = c & 7, y = c >> 3; u.pm = ((x & 3) << 1) | (y & 1); u.pn = i * (G >> 3) + (x >> 2) + 2 * (y >> 1); u.z = 0; return true; }
    __device__ __forceinline__ void ptrs(const Unit& u, const char*& a, const char*& b) const { a = W + (size_t)u.pm * (256 * 256 * 2); b = X + (size_t)u.pn * (256 * 1024 * 2) + (size_t)(u.pm >> 1) * 512; }
};
struct ScanSched {
    const char* vtc; const char* kt; int dir; bool active;
    __device__ __forceinline__ bool next(int i, Unit& u) const { if (!active || i >= 16) return false; u.z = i; u.pm = dir ? 15 - i : i; u.pn = 0; return true; }
    __device__ __forceinline__ void ptrs(const Unit& u, const char*& a, const char*& b) const { a = vtc + (size_t)u.pm * (131072 * 2); b = kt + (size_t)u.pm * (65536 * 2); }
};
struct ScoreSched {
    const char* q; const char* k; int c, stride;
    __device__ __forceinline__ bool next(int i, Unit& u) const { if (c < 0) return false; const int L = i * stride + c; if (L >= 512) return false; u.pm = L; u.pn = 0; u.z = 0; return true; }
    __device__ __forceinline__ void ptrs(const Unit& u, const char*& a, const char*& b) const { a = q + (size_t)u.pm * (65536 * 2); b = k + (size_t)u.pm * (65536 * 2); }
};
struct OutSched {
    const char* scr; int G, c;
    __device__ __forceinline__ bool next(int i, Unit& u) const { const int k = i / 3; if (k * G + c >= 1024) return false; u.pn = (c >> 3) & 1; u.pm = k * (G >> 1) + (c & 7) + 8 * (c >> 4); u.z = i - k * 3; return true; }
    __device__ __forceinline__ void ptrs(const Unit& u, const char*& a, const char*& b) const {
        const size_t ro = ((size_t)u.pm * 512 + (size_t)u.pn * 256) * 256 * 2;
        const size_t z1 = (size_t)(u.z == 1), z2 = (size_t)(u.z == 2);
        a = scr + R_Q + z2 * (R_P - R_Q) + (size_t)u.pm * (65536 * 2);
        b = scr + R_RB - z1 * (R_RB - R_RF) - z2 * (R_RB - R_VTC) + ro; }
};

__device__ __forceinline__ void tr_write8(LAS unsigned char* tw, int r, int fq, const u32x4 w) {
#pragma unroll
    for (int i = 0; i < 8; ++i) { const unsigned v = w[i >> 1];
        *(LAS unsigned short*)(tw + (fq * 8 + i) * 128 + ((((r >> 3) ^ ((i ^ fq) & 7))) << 4) + (r & 7) * 2) = (unsigned short)((i & 1) ? (v >> 16) : (v & 0xffffu)); }
}
struct EpiR1 {
    typedef PreRs Pre;
    __device__ __forceinline__ void pre_load(const Unit& u, int wr, int fr, int fq, Pre& P) const { pre_rs(P, ssq, tok0 + u.pm * 256, wr, fr, fq); }
    static constexpr bool PERM = true, KEEP = false;
    const float* ssq; const unsigned* rope; const float* decay; bf16_t* q; bf16_t* k; bf16_t* ktf; bf16_t* ktb; bf16_t* vtc; int tok0; LAS unsigned char* tl;
    __device__ __forceinline__ void operator()(f32x4 (&acc)[2][2][4][2], const Unit& u, int wr, int wc, int fr, int fq, const Pre& pre) const {
        const int bl = u.pm >> 4, chunk = u.pm & 15, cbase = wc * 32 + fq * 8;
        LAS unsigned char* tw = tl + (wr * 4 + wc) * 4096;
        const int lane = fq * 16 + fr, tc = lane >> 3, jg = lane & 7;
        const float (&rsv)[8] = pre.rs;
        if (u.pn < 8) {
            const bool isk = u.pn >= 4; const int h = u.pn & 3;
            const float lgf = lg2sig(decay[h]), lgb = lg2sig(decay[4 + h]);
            bf16_t* dst = (isk ? k : q) + ((size_t)(bl * 4 + h) * 4096 + chunk * 256) * 256;
            const size_t tb = ((size_t)(bl * 4 + h) * 16 + chunk) * 65536;
#pragma unroll
            for (int ai = 0; ai < 2; ++ai) {
                u32x4 w2s[4];
#pragma unroll
                for (int m = 0; m < 4; ++m) {
                    if (m == 0) asm volatile("" ::: "memory");
                    const int j = ai * 128 + wr * 64 + m * 16 + fr; const int tok = tok0 + u.pm * 256 + j;
                    const float rs = rsv[ai * 4 + m];
                    const u32x4 r0 = *(const u32x4*)(rope + (size_t)tok * 128 + cbase), r1 = *(const u32x4*)(rope + (size_t)tok * 128 + cbase + 4);
                    float o1[8], o2[8];
#pragma unroll
                    for (int n = 0; n < 2; ++n)
#pragma unroll
                        for (int jj = 0; jj < 4; ++jj) {
                            const h16x2 cs = __builtin_bit_cast(h16x2, n == 0 ? r0[jj] : r1[jj]); const float c = (float)cs.x, s = (float)cs.y;
                            const float x1 = acc[ai][0][m][n][jj] * rs, x2 = acc[ai][1][m][n][jj] * rs;
                            o1[n * 4 + jj] = x1 * c - x2 * s; o2[n * 4 + jj] = x1 * s + x2 * c; }
                    u32x4 w1, w2;
                    w1.x = cvt_pk_bf16(o1[0], o1[1]); w1.y = cvt_pk_bf16(o1[2], o1[3]); w1.z = cvt_pk_bf16(o1[4], o1[5]); w1.w = cvt_pk_bf16(o1[6], o1[7]);
                    w2.x = cvt_pk_bf16(o2[0], o2[1]); w2.y = cvt_pk_bf16(o2[2], o2[3]); w2.z = cvt_pk_bf16(o2[4], o2[5]); w2.w = cvt_pk_bf16(o2[6], o2[7]);
                    *(u32x4*)(dst + (size_t)j * 256 + cbase) = w1; *(u32x4*)(dst + (size_t)j * 256 + cbase + 128) = w2;
                    if (isk) { tr_write8(tw, m * 16 + fr, fq, w1); w2s[m] = w2; }
                }
                if (isk) {
                    const int jb = ai * 128 + wr * 64 + jg * 8;
                    float zf[8], zb[8];
#pragma unroll
                    for (int i = 0; i < 8; ++i) { zf[i] = EX2(lgf * (float)(255 - jb - i)); zb[i] = EX2(lgb * (float)(jb + i)); }
#pragma unroll
                    for (int grp = 0; grp < 2; ++grp) {
                        if (grp == 1) {
#pragma unroll
                            for (int m = 0; m < 4; ++m) tr_write8(tw, m * 16 + fr, fq, w2s[m]);
                        }
#pragma unroll
                        for (int ps = 0; ps < 4; ++ps) {
                            const int c = ps * 8 + tc; const u32x4 rd = *(const LAS u32x4*)(tw + c * 128 + ((jg ^ ((tc ^ ps) & 7)) << 4));
                            const size_t e = tb + (size_t)(wc * 32 + grp * 128 + c) * 256 + jb;
                            u32x4 a, b;
#pragma unroll
                            for (int t = 0; t < 4; ++t) { const float lo = bflo(rd[t]), hi = bfhi(rd[t]);
                                a[t] = cvt_pk_bf16(lo * zf[2 * t], hi * zf[2 * t + 1]); b[t] = cvt_pk_bf16(lo * zb[2 * t], hi * zb[2 * t + 1]); }
                            __builtin_nontemporal_store(a, (u32x4*)(ktf + e)); __builtin_nontemporal_store(b, (u32x4*)(ktb + e)); }
                    }
                }
            }
        } else {
            const int h = (u.pn - 8) >> 1, eh = ((u.pn - 8) & 1) * 256;
            const size_t tb = ((size_t)(bl * 4 + h) * 16 + chunk) * 131072;
#pragma unroll
            for (int ai = 0; ai < 2; ++ai)
#pragma unroll
                for (int bj = 0; bj < 2; ++bj) {
#pragma unroll
                    for (int m = 0; m < 4; ++m) { const float rs = rsv[ai * 4 + m]; const f32x4 v0 = acc[ai][bj][m][0] * rs, v1 = acc[ai][bj][m][1] * rs;
                        u32x4 w; w.x = cvt_pk_bf16(v0[0], v0[1]); w.y = cvt_pk_bf16(v0[2], v0[3]); w.z = cvt_pk_bf16(v1[0], v1[1]); w.w = cvt_pk_bf16(v1[2], v1[3]);
                        tr_write8(tw, m * 16 + fr, fq, w); }
#pragma unroll
                    for (int ps = 0; ps < 4; ++ps) {
                        const int c = ps * 8 + tc; const u32x4 rd = *(const LAS u32x4*)(tw + c * 128 + ((jg ^ ((tc ^ ps) & 7)) << 4));
                        __builtin_nontemporal_store(rd, (u32x4*)(vtc + tb + (size_t)(eh + bj * 128 + wc * 32 + c) * 256 + ai * 128 + wr * 64 + jg * 8)); }
                }
        }
    }
};
struct EpiScore {
    typedef PreNone Pre;
    __device__ __forceinline__ void pre_load(const Unit& u, int wr, int fr, int fq, Pre& P) const {  }
    static constexpr bool PERM = true, KEEP = false;
    const float* decay; bf16_t* P;
    __device__ __forceinline__ void operator()(f32x4 (&acc)[2][2][4][2], const Unit& u, int wr, int wc, int fr, int fq, const Pre& pre) const {
        const int h = (u.pm >> 4) & 3; const float lgf = lg2sig(decay[h]), lgb = lg2sig(decay[4 + h]);
        bf16_t* dst = P + (size_t)u.pm * 65536;
#pragma unroll
        for (int ai = 0; ai < 2; ++ai)
#pragma unroll
            for (int m = 0; m < 4; ++m) {
                const int a = ai * 128 + wr * 64 + m * 16 + fr;
#pragma unroll
                for (int bj = 0; bj < 2; ++bj) {
                    const int b0 = bj * 128 + wc * 32 + fq * 8; float v[8];
#pragma unroll
                    for (int n = 0; n < 2; ++n)
#pragma unroll
                        for (int jj = 0; jj < 4; ++jj) { const float df = (float)(a - (b0 + n * 4 + jj)); const float dm = EX2(lgf * fmaxf(df, 0.f) + lgb * fmaxf(-df, 0.f)); v[n * 4 + jj] = acc[ai][bj][m][n][jj] * dm; }
                    u32x4 w; w.x = cvt_pk_bf16(v[0], v[1]); w.y = cvt_pk_bf16(v[2], v[3]); w.z = cvt_pk_bf16(v[4], v[5]); w.w = cvt_pk_bf16(v[6], v[7]);
                    *(u32x4*)(dst + (size_t)a * 256 + b0) = w; }
            }
    }
};
struct EpiScan {
    typedef PreNone Pre;
    __device__ __forceinline__ void pre_load(const Unit& u, int wr, int fr, int fq, Pre& P) const {  }
    static constexpr bool PERM = true, KEEP = true;
    bf16_t* rt; int dir; const float* dptr;
    __device__ __forceinline__ void operator()(f32x4 (&acc)[2][2][4][2], const Unit& u, int wr, int wc, int fr, int fq, const Pre& pre) const {
        const float g = EX2(256.f * lg2sig(*dptr));
        const int target = dir ? u.pm - 1 : u.pm + 1;
        if (target >= 0 && target < 16) {
            bf16_t* dst = rt + (size_t)target * 131072;
#pragma unroll
            for (int ai = 0; ai < 2; ++ai)
#pragma unroll
                for (int m = 0; m < 4; ++m) {
                    const int e = ai * 128 + wr * 64 + m * 16 + fr;
#pragma unroll
                    for (int bj = 0; bj < 2; ++bj) { const f32x4 v0 = acc[ai][bj][m][0], v1 = acc[ai][bj][m][1];
                        u32x4 w; w.x = cvt_pk_bf16(v0[0], v0[1]); w.y = cvt_pk_bf16(v0[2], v0[3]); w.z = cvt_pk_bf16(v1[0], v1[1]); w.w = cvt_pk_bf16(v1[2], v1[3]);
                        __builtin_nontemporal_store(w, (u32x4*)(dst + (size_t)e * 256 + bj * 128 + wc * 32 + fq * 8)); }
                }
        }
#pragma unroll
        for (int ai = 0; ai < 2; ++ai)
#pragma unroll
            for (int bj = 0; bj < 2; ++bj)
#pragma unroll
                for (int m = 0; m < 4; ++m)
#pragma unroll
                    for (int n = 0; n < 2; ++n) acc[ai][bj][m][n] *= g;
    }
};
struct EpiOut {
    typedef PreNone Pre;
    __device__ __forceinline__ void pre_load(const Unit& u, int wr, int fr, int fq, Pre& P) const {  }
    static constexpr bool PERM = true, KEEP = true;
    const float* decay; bf16_t* o; float* gst;
    __device__ __forceinline__ void operator()(f32x4 (&acc)[2][2][4][2], const Unit& u, int wr, int wc, int fr, int fq, const Pre& pre) const {
        const int bh = u.pm >> 4, chunk = u.pm & 15, h = bh & 3, bl = bh >> 2;
        const float lgf = lg2sig(decay[h]), lgb = lg2sig(decay[4 + h]);
        const float kf = u.z == 0 ? -lgf : (u.z == 1 ? lgf : 0.f), kb = u.z == 0 ? lgb : 0.f, kz = u.z == 2 ? 0.f : 1.f;
#pragma unroll
        for (int ai = 0; ai < 2; ++ai)
#pragma unroll
            for (int m = 0; m < 4; ++m) {
                const int a = ai * 128 + wr * 64 + m * 16 + fr;
                if (u.z == 2) {
                    const int tl = bl * 4096 + chunk * 256 + a;
                    float s1 = 0.f, s2 = 0.f;
#pragma unroll
                    for (int bj = 0; bj < 2; ++bj) { const f32x4 v0 = acc[ai][bj][m][0], v1 = acc[ai][bj][m][1];
                        s1 += sum4(v0) + sum4(v1); s2 += sum4(v0 * v0) + sum4(v1 * v1);
                        u32x4 w; w.x = cvt_pk_bf16(v0[0], v0[1]); w.y = cvt_pk_bf16(v0[2], v0[3]); w.z = cvt_pk_bf16(v1[0], v1[1]); w.w = cvt_pk_bf16(v1[2], v1[3]);
                        __builtin_nontemporal_store(w, (u32x4*)(o + (size_t)tl * 2048 + h * 512 + u.pn * 256 + bj * 128 + wc * 32 + fq * 8)); }
                    s1 += __shfl_xor(s1, 16); s1 += __shfl_xor(s1, 32); s2 += __shfl_xor(s2, 16); s2 += __shfl_xor(s2, 32);
                    if (fq == 0) *(f32x2*)(gst + (((size_t)tl * 4 + h) * 8 + u.pn * 4 + wc) * 2) = (f32x2){s1, s2};
                }
                const float sc = kz * EX2(kf * (float)(a + 1) + kb * (float)(256 - a));
#pragma unroll
                for (int bj = 0; bj < 2; ++bj)
#pragma unroll
                    for (int n = 0; n < 2; ++n) acc[ai][bj][m][n] *= sc;
                asm volatile("" ::: "memory");
            }
    }
};
struct EpiGate {
    typedef PreRs Pre;
    __device__ __forceinline__ void pre_load(const Unit& u, int wr, int fr, int fq, Pre& P) const { pre_rs(P, ssq, tok0 + u.pm * 256, wr, fr, fq); }
    static constexpr bool PERM = true, KEEP = false;
    const float* ssq; const float* gst; const float* gng; bf16_t* o; int tok0;
    __device__ __forceinline__ void operator()(f32x4 (&acc)[2][2][4][2], const Unit& u, int wr, int wc, int fr, int fq, const Pre& pre) const {
        const int h = u.pn >> 1, c0 = u.pn * 256 + wc * 32 + fq * 8;
        f32x4 gg[2][2];
#pragma unroll
        for (int bj = 0; bj < 2; ++bj) { gg[bj][0] = *(const f32x4*)(gng + c0 + bj * 128); gg[bj][1] = *(const f32x4*)(gng + c0 + bj * 128 + 4); }
        float rsv[8], muv[8], grv[8];
#pragma unroll
        for (int i = 0; i < 8; ++i) {
            const int tl = u.pm * 256 + (i >> 2) * 128 + wr * 64 + (i & 3) * 16 + fr;
            rsv[i] = pre.rs[i];
            const f32x4 st = *(const f32x4*)(gst + ((size_t)tl * 4 + h) * 16 + fq * 4);
            float s1 = st[0] + st[2], s2 = st[1] + st[3];
            s1 += __shfl_xor(s1, 16); s1 += __shfl_xor(s1, 32); s2 += __shfl_xor(s2, 16); s2 += __shfl_xor(s2, 32);
            muv[i] = s1 * (1.f / 512.f); grv[i] = rsqrtf(fmaxf(s2 * (1.f / 512.f) - muv[i] * muv[i], 0.f) + 1e-6f); }
#pragma unroll
        for (int ai = 0; ai < 2; ++ai)
#pragma unroll
            for (int m = 0; m < 4; ++m) {
                const int tl = u.pm * 256 + ai * 128 + wr * 64 + m * 16 + fr;
                if (m == 0) asm volatile("" ::: "memory");
                const float rs = rsv[ai * 4 + m], mu = muv[ai * 4 + m], gr = grv[ai * 4 + m];
#pragma unroll
                for (int bj = 0; bj < 2; ++bj) {
                    bf16_t* op = o + (size_t)tl * 2048 + c0 + bj * 128;
                    const u32x4 ov = *(const u32x4*)op; float y[8];
#pragma unroll
                    for (int n = 0; n < 2; ++n)
#pragma unroll
                        for (int jj = 0; jj < 4; ++jj) { const unsigned w = ov[n * 2 + (jj >> 1)]; const float oval = (jj & 1) ? bfhi(w) : bflo(w);
                            y[n * 4 + jj] = silu_f(acc[ai][bj][m][n][jj] * rs) * gg[bj][n][jj] * (oval - mu) * gr; }
                    u32x4 w; w.x = cvt_pk_bf16(y[0], y[1]); w.y = cvt_pk_bf16(y[2], y[3]); w.z = cvt_pk_bf16(y[4], y[5]); w.w = cvt_pk_bf16(y[6], y[7]);
                    *(u32x4*)op = w; }
            }
    }
};
template <bool GATED> struct EpiResid {
    static constexpr bool PERM = true, KEEP = false;
    typedef PreRs Pre;
    __device__ __forceinline__ void pre_load(const Unit& u, int wr, int fr, int fq, Pre& P) const { if (GATED) pre_rs(P, ssq_in, tok0 + u.pm * 256, wr, fr, fq); }
    const bf16_t* xin; bf16_t* xout; float* ssq_out; const float* ssq_in; const bf16_t* pp; int tok0; float* xf32;
    __device__ __forceinline__ void operator()(f32x4 (&acc)[2][2][4][2], const Unit& u, int wr, int wc, int fr, int fq, const Pre& pre) const {
        const int c0 = u.pn * 256 + wc * 32 + fq * 8;
#pragma unroll
        for (int ai = 0; ai < 2; ++ai) {
            u32x4 pv[4][2];
            if (GATED) {
#pragma unroll
                for (int m = 0; m < 4; ++m)
#pragma unroll
                    for (int bj = 0; bj < 2; ++bj) pv[m][bj] = *(const u32x4*)(pp + (size_t)(tok0 + u.pm * 256 + ai * 128 + wr * 64 + m * 16 + fr) * 1024 + c0 + bj * 128);
            }
#pragma unroll
            for (int m = 0; m < 4; ++m) {
                const int tok = tok0 + u.pm * 256 + ai * 128 + wr * 64 + m * 16 + fr;
                const float nrl = GATED ? -1.4426950408889634f * pre.rs[ai * 4 + m] : 0.f;
                f32x4 ssv = (f32x4){0.f, 0.f, 0.f, 0.f};
#pragma unroll
                for (int bj = 0; bj < 2; ++bj) {
                    const size_t off = (size_t)tok * 1024 + c0 + bj * 128;
                    const u32x4 xv = *(const u32x4*)(xin + off);
                    f32x4 v0 = (f32x4){bflo(xv.x), bfhi(xv.x), bflo(xv.y), bfhi(xv.y)}, v1 = (f32x4){bflo(xv.z), bfhi(xv.z), bflo(xv.w), bfhi(xv.w)};
                    if (GATED) {
                        const u32x4 pw = pv[m][bj];
                        const f32x4 p0 = (f32x4){bflo(pw.x), bfhi(pw.x), bflo(pw.y), bfhi(pw.y)}, p1 = (f32x4){bflo(pw.z), bfhi(pw.z), bflo(pw.w), bfhi(pw.w)};
                        const f32x4 t0 = acc[ai][bj][m][0] * nrl, t1 = acc[ai][bj][m][1] * nrl;
                        f32x4 e0, e1; e0[0] = EX2(t0[0]); e0[1] = EX2(t0[1]); e0[2] = EX2(t0[2]); e0[3] = EX2(t0[3]); e1[0] = EX2(t1[0]); e1[1] = EX2(t1[1]); e1[2] = EX2(t1[2]); e1[3] = EX2(t1[3]);
                        const f32x4 d0 = e0 + 1.0f, d1 = e1 + 1.0f;
                        f32x4 r0, r1; r0[0] = __builtin_amdgcn_rcpf(d0[0]); r0[1] = __builtin_amdgcn_rcpf(d0[1]); r0[2] = __builtin_amdgcn_rcpf(d0[2]); r0[3] = __builtin_amdgcn_rcpf(d0[3]);
                        r1[0] = __builtin_amdgcn_rcpf(d1[0]); r1[1] = __builtin_amdgcn_rcpf(d1[1]); r1[2] = __builtin_amdgcn_rcpf(d1[2]); r1[3] = __builtin_amdgcn_rcpf(d1[3]);
                        v0 += r0 * p0; v1 += r1 * p1; }
                    else { v0 += acc[ai][bj][m][0]; v1 += acc[ai][bj][m][1]; }
                    ssv += v0 * v0; ssv += v1 * v1;
                    if (GATED && xf32) { *(f32x4*)(xf32 + off) = v0; *(f32x4*)(xf32 + off + 4) = v1; }
                    else { u32x4 w; w.x = cvt_pk_bf16(v0[0], v0[1]); w.y = cvt_pk_bf16(v0[2], v0[3]); w.z = cvt_pk_bf16(v1[0], v1[1]); w.w = cvt_pk_bf16(v1[2], v1[3]); *(u32x4*)(xout + off) = w; } }
                float ss = sum4(ssv);
                ss += __shfl_xor(ss, 16); ss += __shfl_xor(ss, 32);
                if (fq == 0) ssq_out[(size_t)tok * 16 + u.pn * 4 + wc] = ss;
            }
            asm volatile("" ::: "memory");
        }
    }
};
struct EpiF1 {
    typedef PreRs Pre;
    __device__ __forceinline__ void pre_load(const Unit& u, int wr, int fr, int fq, Pre& P) const { pre_rs(P, ssq, u.pm * 256, wr, fr, fq); }
    static constexpr bool PERM = true, KEEP = false;
    const float* ssq; bf16_t* H;
    __device__ __forceinline__ void operator()(f32x4 (&acc)[2][2][4][2], const Unit& u, int wr, int wc, int fr, int fq, const Pre& pre) const {
#pragma unroll
        for (int ai = 0; ai < 2; ++ai)
#pragma unroll
            for (int m = 0; m < 4; ++m) {
                const int tok = u.pm * 256 + ai * 128 + wr * 64 + m * 16 + fr;
                const float rs = pre.rs[ai * 4 + m]; const float nrl = -1.4426950408889634f * rs, rs2 = rs * rs; f32x4 hv[2];
#pragma unroll
                for (int n = 0; n < 2; ++n) {
                    const f32x4 g4 = acc[ai][0][m][n], u4 = acc[ai][1][m][n]; const f32x4 t4 = g4 * nrl;
                    f32x4 e4; e4[0] = EX2(t4[0]); e4[1] = EX2(t4[1]); e4[2] = EX2(t4[2]); e4[3] = EX2(t4[3]);
                    const f32x4 d4 = e4 + 1.0f;
                    f32x4 r4; r4[0] = __builtin_amdgcn_rcpf(d4[0]); r4[1] = __builtin_amdgcn_rcpf(d4[1]); r4[2] = __builtin_amdgcn_rcpf(d4[2]); r4[3] = __builtin_amdgcn_rcpf(d4[3]);
                    hv[n] = (g4 * u4) * (r4 * rs2); }
                u32x4 w; w.x = cvt_pk_bf16(hv[0][0], hv[0][1]); w.y = cvt_pk_bf16(hv[0][2], hv[0][3]); w.z = cvt_pk_bf16(hv[1][0], hv[1][1]); w.w = cvt_pk_bf16(hv[1][2], hv[1][3]);
                __builtin_nontemporal_store(w, (u32x4*)(H + (size_t)tok * DFF + u.pn * 128 + wc * 32 + fq * 8));
            }
    }
};
template <bool ZMAP> struct EpiPlain {
    typedef PreNone Pre;
    __device__ __forceinline__ void pre_load(const Unit& u, int wr, int fr, int fq, Pre& P) const {  }
    static constexpr bool PERM = true, KEEP = false;
    bf16_t* C; int ldc;
    __device__ __forceinline__ void operator()(f32x4 (&acc)[2][2][4][2], const Unit& u, int wr, int wc, int fr, int fq, const Pre& pre) const {
#pragma unroll
        for (int ai = 0; ai < 2; ++ai)
#pragma unroll
            for (int m = 0; m < 4; ++m) {
                const int r = u.pm * 256 + ai * 128 + wr * 64 + m * 16 + fr;
                bf16_t* rowp = ZMAP ? C + ((size_t)(u.pn >> 2) * 4096 + r) * 1024 + (u.pn & 3) * 256 : C + (size_t)r * ldc + u.pn * 256;
#pragma unroll
                for (int bj = 0; bj < 2; ++bj) { const f32x4 v0 = acc[ai][bj][m][0], v1 = acc[ai][bj][m][1];
                    u32x4 w; w.x = cvt_pk_bf16(v0[0], v0[1]); w.y = cvt_pk_bf16(v0[2], v0[3]); w.z = cvt_pk_bf16(v1[0], v1[1]); w.w = cvt_pk_bf16(v1[2], v1[3]);
                    *(u32x4*)(rowp + bj * 128 + wc * 32 + fq * 8) = w; }
            }
    }
};
struct Z2Sched {
    const char* D; const char* Z; int G, c;
    __device__ __forceinline__ bool next(int i, Unit& u) const { const int r = i >> 1; if (r * G + c >= 512) return false; const int x = c & 7, y = c >> 3; u.pm = y & 7; u.pn = r * (G >> 3) + x * 4 + (y >> 3); u.z = (i & 1) | (r << 1); return true; }
    __device__ __forceinline__ void ptrs(const Unit& u, const char*& a, const char*& b) const {
        const size_t so = (size_t)(u.z & 1) * 4096;
        a = D + (size_t)u.pm * (256 * 4096 * 2) + so; b = Z + (size_t)u.pn * (256 * 4096 * 2) + so; }
};
struct EpiZ2 {
    typedef PreNone Pre;
    __device__ __forceinline__ void pre_load(const Unit& u, int wr, int fr, int fq, Pre& P) const {  }
    static constexpr bool PERM = true, KEEP = true;
    bf16_t* Fo; float* stash; const bf16_t* nyq;
    __device__ __forceinline__ void operator()(f32x4 (&acc)[2][2][4][2], const Unit& u, int wr, int wc, int fr, int fq, const Pre& pre) const {
        const int tid = (wr * 4 + wc) * 64 + fq * 16 + fr;
        float* st = stash + (size_t)(u.z >> 1) * 65536 + (size_t)tid * 4;
        if ((u.z & 1) == 0) {
#pragma unroll
            for (int ai = 0; ai < 2; ++ai)
#pragma unroll
                for (int m = 0; m < 4; ++m)
#pragma unroll
                    for (int bj = 0; bj < 2; ++bj)
#pragma unroll
                        for (int n = 0; n < 2; ++n) *(f32x4*)(st + (size_t)((((ai * 4 + m) * 2 + bj) * 2 + n) * 2048)) = acc[ai][bj][m][n];
        } else {
            const int b = u.pn >> 2, g = u.pn & 3;
            const float sgn = (fr & 1) ? -1.f : 1.f;
            f32x4 ny[2][2];
#pragma unroll
            for (int bj = 0; bj < 2; ++bj) { const u32x4 nv = *(const u32x4*)(nyq + (size_t)u.pn * 256 + bj * 128 + wc * 32 + fq * 8);
                ny[bj][0] = (f32x4){bflo(nv.x), bfhi(nv.x), bflo(nv.y), bfhi(nv.y)} * sgn; ny[bj][1] = (f32x4){bflo(nv.z), bfhi(nv.z), bflo(nv.w), bfhi(nv.w)} * sgn; }
#pragma unroll
            for (int ai = 0; ai < 2; ++ai)
#pragma unroll
                for (int m = 0; m < 4; ++m) {
                    const int kk = u.pm * 256 + ai * 128 + wr * 64 + m * 16 + fr;
                    bf16_t* r1 = Fo + ((size_t)b * 4096 + kk) * 1024 + g * 256 + wc * 32 + fq * 8;
                    bf16_t* r2 = Fo + ((size_t)b * 4096 + (4096 - kk)) * 1024 + g * 256 + wc * 32 + fq * 8;
#pragma unroll
                    for (int bj = 0; bj < 2; ++bj) {
                        const f32x4 c0 = *(const f32x4*)(st + (size_t)((((ai * 4 + m) * 2 + bj) * 2 + 0) * 2048)) + ny[bj][0], c1 = *(const f32x4*)(st + (size_t)((((ai * 4 + m) * 2 + bj) * 2 + 1) * 2048)) + ny[bj][1];
                        const f32x4 s0 = acc[ai][bj][m][0], s1 = acc[ai][bj][m][1];
                        const f32x4 p0 = c0 + s0, p1 = c1 + s1, q0 = c0 - s0, q1 = c1 - s1;
                        u32x4 w; w.x = cvt_pk_bf16(p0[0], p0[1]); w.y = cvt_pk_bf16(p0[2], p0[3]); w.z = cvt_pk_bf16(p1[0], p1[1]); w.w = cvt_pk_bf16(p1[2], p1[3]);
                        *(u32x4*)(r1 + bj * 128) = w;
                        u32x4 x; x.x = cvt_pk_bf16(q0[0], q0[1]); x.y = cvt_pk_bf16(q0[2], q0[3]); x.z = cvt_pk_bf16(q1[0], q1[1]); x.w = cvt_pk_bf16(q1[2], q1[3]);
                        if (kk != 0) *(u32x4*)(r2 + bj * 128) = x; }
                    if (m & 1) asm volatile("" ::: "memory");
                }
        }
#pragma unroll
        for (int ai = 0; ai < 2; ++ai)
#pragma unroll
            for (int bj = 0; bj < 2; ++bj)
#pragma unroll
                for (int m = 0; m < 4; ++m)
#pragma unroll
                    for (int n = 0; n < 2; ++n) acc[ai][bj][m][n] *= 0.f;
    }
};
struct EpiZ1 {
    typedef PreNone Pre;
    __device__ __forceinline__ void pre_load(const Unit& u, int wr, int fr, int fq, Pre& P) const {  }
    static constexpr bool PERM = true, KEEP = false;
    const float* ssq; bf16_t* zp;
    __device__ __forceinline__ void operator()(f32x4 (&acc)[2][2][4][2], const Unit& u, int wr, int wc, int fr, int fq, const Pre& pre) const {
        const int gg = u.pm >> 1, ri = u.pm & 1, b = u.pn >> 4, s0 = (u.pn & 15) * 256;
        float rs[2][8];
#pragma unroll
        for (int bj = 0; bj < 2; ++bj)
#pragma unroll
            for (int i = 0; i < 8; ++i) { const int tok = u.pn * 256 + bj * 128 + wc * 32 + fq * 8 + i;
                float s = ssq[(size_t)tok * 16 + fr]; s += __shfl_xor(s, 1); s += __shfl_xor(s, 2); s += __shfl_xor(s, 4); s += __shfl_xor(s, 8);
                rs[bj][i] = rsqrtf(s * (1.f / 1024.f) + 1e-6f); }
#pragma unroll
        for (int ai = 0; ai < 2; ++ai)
#pragma unroll
            for (int m = 0; m < 4; ++m) {
                const int l = ai * 128 + wr * 64 + m * 16 + fr;
                bf16_t* rowp = zp + ((size_t)((b * 4 + gg) * 256 + l)) * 8192 + ri * 4096 + s0;
#pragma unroll
                for (int bj = 0; bj < 2; ++bj) { const f32x4 v0 = acc[ai][bj][m][0], v1 = acc[ai][bj][m][1];
                    u32x4 w; w.x = cvt_pk_bf16(v0[0] * rs[bj][0], v0[1] * rs[bj][1]); w.y = cvt_pk_bf16(v0[2] * rs[bj][2], v0[3] * rs[bj][3]);
                    w.z = cvt_pk_bf16(v1[0] * rs[bj][4], v1[1] * rs[bj][5]); w.w = cvt_pk_bf16(v1[2] * rs[bj][6], v1[3] * rs[bj][7]);
                    *(u32x4*)(rowp + bj * 128 + wc * 32 + fq * 8) = w; }
            }
    }
};

__device__ __forceinline__ void conv_wt(const float* __restrict__ W, int K, int N, bf16_t* __restrict__ dst, const float* __restrict__ gain, int mode, int cs_lo, int cs_hi, float cs, size_t gtid, size_t gstride) {
    const size_t total = (size_t)(K / 8) * N;
#pragma unroll 4
    for (size_t idx = gtid; idx < total; idx += gstride) {
        const int n = (int)(idx % N), k0 = (int)(idx / N) * 8; float v[8];
        const float sc = (n >= cs_lo && n < cs_hi) ? cs : 1.f;
#pragma unroll
        for (int j = 0; j < 8; ++j) { v[j] = W[(size_t)(k0 + j) * N + n] * sc; if (gain) v[j] *= gain[k0 + j]; }
        const int drow = mode == 0 ? n : ((n >> 7) * 256 + (mode == 2 ? 128 : 0) + (n & 127));
        u32x4 w; w.x = cvt_pk_bf16(v[0], v[1]); w.y = cvt_pk_bf16(v[2], v[3]); w.z = cvt_pk_bf16(v[4], v[5]); w.w = cvt_pk_bf16(v[6], v[7]);
        *(u32x4*)(dst + (size_t)drow * K + k0) = w;
    }
}

__device__ __forceinline__ void phase_prep(const Params& p) {
    const size_t gtid = (size_t)blockIdx.x * blockDim.x + threadIdx.x, gstride = (size_t)gridDim.x * blockDim.x;
    bf16_t* wb = (bf16_t*)(p.ws + WS_W);
    for (int j = 0; j < 2; ++j) {
        conv_wt(p.ret_w_in + (size_t)j * 1024 * 6144, 1024, 6144, wb + W_IN + (size_t)j * 6291456, p.norm_mix + (size_t)(2 * j) * 1024, 0, 1024, 2048, 0.0625f, gtid, gstride);
        conv_wt(p.ret_w_out + (size_t)j * 2048 * 1024, 2048, 1024, wb + W_OUT + (size_t)j * 2097152, nullptr, 0, 0, 0, 1.f, gtid, gstride);
        conv_wt(p.fno_w + (size_t)j * 1048576, 1024, 1024, wb + W_FNO + (size_t)j * 1048576, nullptr, 0, 0, 0, 1.f, gtid, gstride);
        const float* gain = p.norm_mix + (size_t)(2 * j + 1) * 1024;
        for (size_t idx = gtid; idx < 524288; idx += gstride) { const int c = (int)(idx & 255), np = (int)((idx >> 8) & 511), g = (int)(idx >> 17);
            const float ph = (float)((c * (np & 255)) & 255) * (1.f / 256.f);
            const float v = (np < 256 ? __builtin_amdgcn_cosf(ph) : -__builtin_amdgcn_sinf(ph)) * gain[g * 256 + c] * (1.f / 1024.f);
            wb[W_DFT + (size_t)j * 524288 + idx] = f2bf(v); }
    }
    for (int i = 0; i < 4; ++i) {
        conv_wt(p.w_gate + (size_t)i * 1024 * DFF, 1024, DFF, wb + W_GU + (size_t)i * 5767168, p.norm_ffn + (size_t)i * 1024, 1, 0, 0, 1.f, gtid, gstride);
        conv_wt(p.w_up + (size_t)i * 1024 * DFF, 1024, DFF, wb + W_GU + (size_t)i * 5767168, p.norm_ffn + (size_t)i * 1024, 2, 0, 0, 1.f, gtid, gstride);
        conv_wt(p.w_down + (size_t)i * DFF * 1024, DFF, 1024, wb + W_DN + (size_t)i * 2883584, nullptr, 0, 0, 0, 1.f, gtid, gstride);
        conv_wt(p.ple_wg + (size_t)i * 1048576, 1024, 1024, wb + W_PG + (size_t)i * 1048576, p.norm_ple + (size_t)i * 1024, 0, 0, 0, 1.f, gtid, gstride);
        conv_wt(p.ple_wp + (size_t)i * 262144, 256, 1024, wb + W_PP + (size_t)i * 262144, nullptr, 0, 0, 0, 1.f, gtid, gstride);
    }
    unsigned* __restrict__ rope = (unsigned*)(p.ws + WS_ROPE); const int* __restrict__ posp = p.pos;
#pragma unroll 4
    for (size_t idx = gtid; idx < (size_t)T * 128; idx += gstride) {
        const int d = (int)(idx & 127); const int tok = (int)(idx >> 7);
        const float freq = 1.0f / exp2f(13.287712379549449f * ((float)d * (1.0f / 127.0f)));
        const float ang = (float)posp[tok] * freq;
        const double rev = (double)ang * 0.15915494309189535; const float fr = (float)(rev - __builtin_rint(rev));
        h16x2 cs; cs.x = (_Float16)__builtin_amdgcn_cosf(fr); cs.y = (_Float16)__builtin_amdgcn_sinf(fr);
        rope[idx] = __builtin_bit_cast(unsigned, cs);
    }
    const int lane = threadIdx.x & 63; const size_t gw = gtid >> 6, nw = gstride >> 6;
    bf16_t* xb = (bf16_t*)p.out; float* ssq = (float*)(p.ws + WS_SSQ);
#pragma unroll 2
    for (size_t row = gw; row < (size_t)T; row += nw) {
        float s = 0.f;
#pragma unroll
        for (int j = 0; j < 4; ++j) { const size_t off = row * 1024 + j * 256 + lane * 4; const f32x4 v = *(const f32x4*)(p.x + off); s += sum4(v * v);
            u32x2 w; w.x = cvt_pk_bf16(v[0], v[1]); w.y = cvt_pk_bf16(v[2], v[3]); *(u32x2*)(xb + off) = w; }
#pragma unroll
        for (int o = 1; o < 64; o <<= 1) s += __shfl_xor(s, o);
        if (lane < 16) ssq[row * 16 + lane] = lane == 0 ? s : 0.f;
    }
}

constexpr size_t WS_BAR = 243 * MiB;
#define XB_TMO      128
#define XB_XCNT(j)  (256  + 64 * (j))
#define XB_XSUB(j)  (1280 + 64 * (j))
#define XB_XGEN(j)  (2304 + 64 * (j))
#define XB_TOP      3328
#define XB_TOPGEN   3392
#define XCD_BAR_WORDS 3456
#define XB_SPIN_CAP (1u << 20)
__device__ __forceinline__ unsigned xb_ld(unsigned* p)              { return __hip_atomic_load(p, __ATOMIC_RELAXED, __HIP_MEMORY_SCOPE_AGENT); }
__device__ __forceinline__ unsigned xb_add(unsigned* p, unsigned v) { return __hip_atomic_fetch_add(p, v, __ATOMIC_RELAXED, __HIP_MEMORY_SCOPE_AGENT); }
__device__ __forceinline__ unsigned xb_xcc_id() { return (unsigned)__builtin_amdgcn_s_getreg((3 << 11) | 20) & 0xFu; }
#define XB_SPIN(cond, bar) do { unsigned _sp = 0; while (cond) { __builtin_amdgcn_s_sleep(1); \
    if ((++_sp & 255u) == 0u) { if (xb_ld(&(bar)[XB_TMO])) break; if (_sp > XB_SPIN_CAP) { atomicAdd(&(bar)[XB_TMO], 1u); break; } } } } while (0)
__device__ __forceinline__ void xcd_census(unsigned* bar, unsigned x, unsigned& nloc, unsigned& nx) {
    const unsigned G = gridDim.x; unsigned sum, cnt, mine, sp = 0u;
    for (;;) {
        sum = 0u; cnt = 0u; mine = 0u;
#pragma unroll
        for (unsigned j = 0; j < 16; ++j) { const unsigned c = xb_ld(&bar[XB_XCNT(j)]); sum += c; cnt += (c > 0u) ? 1u : 0u; mine = (j == x) ? c : mine; }
        if (sum == G) break;
        __builtin_amdgcn_s_sleep(1);
        if ((++sp & 255u) == 0u) { if (xb_ld(&bar[XB_TMO])) break; if (sp > XB_SPIN_CAP) { atomicAdd(&bar[XB_TMO], 1u); break; } }
    }
    nloc = mine > 0u ? mine : 1u; nx = cnt > 0u ? cnt : 1u;
}
__device__ __forceinline__ void grid_bar(unsigned* bar) {
    asm volatile("s_waitcnt vmcnt(0)" ::: "memory");
    __syncthreads();
    if (threadIdx.x == 0) {
        __builtin_amdgcn_s_waitcnt(0);
        const unsigned x = xb_xcc_id();
        unsigned* mine = bar + XCD_BAR_WORDS + 2 * blockIdx.x;
        unsigned nloc = mine[0], nx = mine[1];
        if (nloc == 0u) { xcd_census(bar, x, nloc, nx); mine[0] = nloc; mine[1] = nx; }
        const unsigned old = xb_add(&bar[XB_XSUB(x)], 1u);
        const unsigned gen = old / nloc;
        if (old + 1u == (gen + 1u) * nloc) {
            __builtin_amdgcn_fence(__ATOMIC_RELEASE, "agent");
            asm volatile("s_waitcnt vmcnt(0)" ::: "memory");
            const unsigned og = xb_add(&bar[XB_TOP], 1u);
            const unsigned tg = og / nx;
            if (og + 1u == (tg + 1u) * nx) xb_add(&bar[XB_TOPGEN], 1u);
            else XB_SPIN(xb_ld(&bar[XB_TOPGEN]) == tg, bar);
            __builtin_amdgcn_fence(__ATOMIC_ACQUIRE, "agent");
            xb_add(&bar[XB_XGEN(x)], 1u);
            asm volatile("s_waitcnt vmcnt(0)" ::: "memory");
        } else {
            XB_SPIN(xb_ld(&bar[XB_XGEN(x)]) == gen, bar);
            __builtin_amdgcn_fence(__ATOMIC_ACQUIRE, "agent");
            asm volatile("s_waitcnt vmcnt(0)" ::: "memory");
        }
    }
    __syncthreads();
}

__global__ void __launch_bounds__(512, 2) fwd_kernel(const Params p) {
    extern __shared__ __attribute__((aligned(16))) unsigned char shm[];
    LAS unsigned char* lds = (LAS unsigned char*)shm;
#define gtid ((size_t)blockIdx.x * 512 + (size_t)tidl)
#define gstride ((size_t)gridDim.x * 512)
#define scr (ws + WS_SCR)
#define xb (xsel ? (bf16_t*)outl : (bf16_t*)(ws + WS_XB))
#define xb_oth (xsel ? (bf16_t*)(ws + WS_XB) : (bf16_t*)outl)
#define wb ((bf16_t*)(ws + WS_W))
#define ssq0 ((float*)(ws + WS_SSQ))
#define ssq1 ((float*)(ws + WS_SSQ) + (size_t)T * 16)
#define gst ((float*)(ws + WS_GST))
#define q_b ((bf16_t*)(scr + R_Q))
#define k_b ((bf16_t*)(scr + R_K))
#define ktf_b ((bf16_t*)(scr + R_KTF))
#define ktb_b ((bf16_t*)(scr + R_KTB))
#define vtc_b ((bf16_t*)(scr + R_VTC))
#define P_b ((bf16_t*)(scr + R_P))
#define rf_b ((bf16_t*)(scr + R_RF))
#define rb_b ((bf16_t*)(scr + R_RB))
#define o_b ((bf16_t*)(scr + R_O))
#define zp_b ((bf16_t*)(scr + Z_ZP))
#define F_b ((bf16_t*)(scr + Z_F))
#define dseq_b ((bf16_t*)(scr + Z_D))
#define H_b ((bf16_t*)(scr + F_H))
#define pp_b ((bf16_t*)(scr + F_PP))
#define pb_b ((bf16_t*)(scr + F_PB))
    int ph = 0, nrm = 0, xsel = 1;
#if COOP
    cg::grid_group grid = cg::this_grid();
    if (threadIdx.x == 0) (void)xb_add(&((unsigned*)(p.ws + WS_BAR))[XB_XCNT(xb_xcc_id())], 1u);
#define PH_BEGIN if (ph >= p.ph_lo && ph < p.ph_hi) { size_t zofs = 0; asm volatile("" : "+s"(zofs)); unsigned char* ws = p.ws + zofs; int tidl = threadIdx.x; asm volatile("" : "+v"(tidl)); float* outl = p.out + zofs;
#define PH_END if (ph + 1 < p.ph_hi) { if (p.ph_hi < 0) grid.sync(); else grid_bar((unsigned*)(p.ws + WS_BAR)); } } ++ph;
#else
#define PH_BEGIN if (ph >= p.ph_lo && ph < p.ph_hi) { size_t zofs = 0; asm volatile("" : "+s"(zofs)); unsigned char* ws = p.ws + zofs; int tidl = threadIdx.x; asm volatile("" : "+v"(tidl)); float* outl = p.out + zofs;
#define PH_END } ++ph;
#endif
#define SSQ_CUR ((nrm & 1) ? ssq1 : ssq0)
#define SSQ_NXT ((nrm & 1) ? ssq0 : ssq1)

    PH_BEGIN if (PHSEL(0)) phase_prep(p); PH_END

    for (int layer = 0; layer < 4; ++layer) {
        const int jj = layer >> 1;
        if ((layer & 1) == 0) {
#define decay (p.ret_decay + (size_t)jj * 8)
            for (int hf = 0; hf < 2; ++hf) {
                const int tok0 = hf * TH;
                PH_BEGIN if (PHSEL(1)) {
                    TileSched S; S.init(xb + (size_t)tok0 * 1024, wb + W_IN + (size_t)jj * 6291456, 1024, 1024, 128, 16);
                    EpiR1 E{SSQ_CUR, (const unsigned*)(ws + WS_ROPE), decay, q_b, k_b, ktf_b, ktb_b, vtc_b, tok0, lds + STAGE_BYTES};
                    gemm_phase(lds, S, E, 1024, 1024, 16);
                } PH_END
                PH_BEGIN if (PHSEL(2)) {
                    const int c = blockIdx.x;
#if !defined(SUB) || SUB == 0
                    { const bool act = c < 128; const int item = act ? c : 0, yy = item >> 3, bh = (item & 7) + 8 * (yy >> 2), dir = (yy >> 1) & 1, half = yy & 1, h = bh & 3;
                      bf16_t* rt = (dir ? rb_b : rf_b) + (size_t)bh * 16 * 131072 + (size_t)half * 65536;
                      if (act) { bf16_t* z = rt + (size_t)(dir ? 15 : 0) * 131072; unsigned zz = 0u; asm volatile("" : "+v"(zz)); for (int i = tidl; i < 8192; i += 512) *(u32x4*)(z + (size_t)i * 8) = (u32x4){zz, zz, zz, zz}; }
                      ScanSched S{(const char*)(vtc_b + (size_t)bh * 16 * 131072 + (size_t)half * 65536), (const char*)((dir ? ktb_b : ktf_b) + (size_t)bh * 16 * 65536), dir, act};
                      EpiScan E{rt, dir, decay + dir * 4 + h};
                      gemm_phase(lds, S, E, 256, 256, 4); }
#endif
#if !defined(SUB) || SUB == 1
                    { ScoreSched S{(const char*)q_b, (const char*)k_b, c >= 128 ? c - 128 : -1, (int)gridDim.x - 128};
                      EpiScore E{decay, P_b};
                      gemm_phase(lds, S, E, 256, 256, 4); }
#endif
                } PH_END
                PH_BEGIN if (PHSEL(3)) {
                    OutSched S{(const char*)scr, (int)gridDim.x, (int)blockIdx.x};
                    EpiOut E{decay, o_b, gst};
                    gemm_phase(lds, S, E, 256, 256, 4);
                } PH_END
                PH_BEGIN if (PHSEL(4)) {
                    TileSched S; S.init(xb + (size_t)tok0 * 1024, wb + W_IN + (size_t)jj * 6291456 + (size_t)4096 * 1024, 1024, 1024, 128, 8);
                    EpiGate E{SSQ_CUR, gst, p.ret_gn + (size_t)jj * 2048, o_b, tok0};
                    gemm_phase(lds, S, E, 1024, 1024, 16);
                } PH_END
                PH_BEGIN if (PHSEL(5)) {
                    TileSched S; S.init(o_b, wb + W_OUT + (size_t)jj * 2097152, 2048, 2048, 128, 4);
                    EpiResid<false> E{xb, xb, SSQ_NXT, nullptr, nullptr, tok0, nullptr};
                    gemm_phase(lds, S, E, 2048, 2048, 32);
                } PH_END
            }
            ++nrm;
        } else {
            PH_BEGIN if (PHSEL(6)) {
                for (size_t idx = gtid; idx < (size_t)2048 * 512; idx += gstride) { const int kk = (int)(idx >> 9), c8 = (int)(idx & 511) * 8; const int s0 = c8 & 2047; float v[8];
#pragma unroll
                    for (int i = 0; i < 8; ++i) { const float phs = (float)((kk * (s0 + i)) & 4095) * (1.f / 4096.f); v[i] = c8 < 2048 ? __builtin_amdgcn_cosf(phs) : __builtin_amdgcn_sinf(phs); }
                    u32x4 w; w.x = cvt_pk_bf16(v[0], v[1]); w.y = cvt_pk_bf16(v[2], v[3]); w.z = cvt_pk_bf16(v[4], v[5]); w.w = cvt_pk_bf16(v[6], v[7]);
                    *(u32x4*)(dseq_b + (size_t)kk * 4096 + c8) = w; }
                Z1Sched S{(const char*)(wb + W_DFT + (size_t)jj * 524288), (const char*)xb, (int)gridDim.x, (int)blockIdx.x};
                EpiZ1 E{SSQ_CUR, zp_b};
                gemm_phase(lds, S, E, 256, 1024, 4);
            } PH_END
            PH_BEGIN if (PHSEL(13)) {
                bf16_t* zf = (bf16_t*)(scr + Z_ZF); bf16_t* nyq = (bf16_t*)(scr + Z_NY);
#pragma unroll 2
                for (size_t idx = gtid; idx < (size_t)16384 * 256; idx += gstride) { const size_t col = idx >> 8; const int a = (int)(idx & 255) * 8;
                    const bf16_t* zr = zp_b + col * 8192; const bf16_t* zi = zr + 4096;
                    const u32x4 r0 = *(const u32x4*)(zr + a), r1 = *(const u32x4*)(zr + 4088 - a), r2 = *(const u32x4*)(zr + (a ? 4096 - a : 0));
                    const u32x4 i0 = *(const u32x4*)(zi + a), i1 = *(const u32x4*)(zi + 4088 - a), i2 = *(const u32x4*)(zi + (a ? 4096 - a : 0));
                    float dr[8], di[8], mr[8], mi[8];
#pragma unroll
                    for (int j = 0; j < 4; ++j) { dr[2 * j] = bflo(r0[j]); dr[2 * j + 1] = bfhi(r0[j]); di[2 * j] = bflo(i0[j]); di[2 * j + 1] = bfhi(i0[j]); }
#pragma unroll
                    for (int e = 1; e < 8; ++e) { mr[8 - e] = (e & 1) ? bfhi(r1[e >> 1]) : bflo(r1[e >> 1]); mi[8 - e] = (e & 1) ? bfhi(i1[e >> 1]) : bflo(i1[e >> 1]); }
                    mr[0] = a ? bflo(r2[0]) : 0.f; mi[0] = a ? bflo(i2[0]) : 0.f;
                    float er[8], oi[8];
#pragma unroll
                    for (int i = 0; i < 8; ++i) { er[i] = dr[i] + mr[i]; oi[i] = di[i] - mi[i]; }
                    if (a == 0) oi[0] = 0.f;
                    u32x4 w; w.x = cvt_pk_bf16(er[0], er[1]); w.y = cvt_pk_bf16(er[2], er[3]); w.z = cvt_pk_bf16(er[4], er[5]); w.w = cvt_pk_bf16(er[6], er[7]);
                    *(u32x4*)(zf + col * 4096 + a) = w;
                    u32x4 x; x.x = cvt_pk_bf16(oi[0], oi[1]); x.y = cvt_pk_bf16(oi[2], oi[3]); x.z = cvt_pk_bf16(oi[4], oi[5]); x.w = cvt_pk_bf16(oi[6], oi[7]);
                    *(u32x4*)(zf + col * 4096 + 2048 + a) = x;
                    if (a == 0) nyq[col] = zr[2048]; }
            } PH_END
            PH_BEGIN if (PHSEL(7)) {
                Z2Sched S{(const char*)dseq_b, (const char*)(scr + Z_ZF), (int)gridDim.x, (int)blockIdx.x};
                EpiZ2 E{F_b, (float*)(scr + Z_ST) + (size_t)blockIdx.x * 131072, (const bf16_t*)(scr + Z_NY)};
                gemm_phase(lds, S, E, 4096, 4096, 32);
                { const int lane = tidl & 63; const size_t gw = gtid >> 6, nw = gstride >> 6;
                  for (size_t col = gw; col < 16384; col += nw) {
                      float a = 0.f;
#pragma unroll
                      for (int i = 0; i < 8; ++i) { const u32x4 v = *(const u32x4*)(zp_b + col * 8192 + (size_t)i * 512 + lane * 8);
                          a += (bflo(v.x) - bfhi(v.x)) + (bflo(v.y) - bfhi(v.y)) + (bflo(v.z) - bfhi(v.z)) + (bflo(v.w) - bfhi(v.w)); }
#pragma unroll
                      for (int o = 1; o < 64; o <<= 1) a += __shfl_xor(a, o);
                      if (lane == 0) F_b[((size_t)(col >> 10) * 4096 + 2048) * 1024 + (col & 1023)] = f2bf(a); } }
            } PH_END
            PH_BEGIN if (PHSEL(8)) {
                TileSched S; S.init(F_b, wb + W_FNO + (size_t)jj * 1048576, 1024, 1024, 256, 4);
                EpiResid<false> E{xb, xb, SSQ_NXT, nullptr, nullptr, 0, nullptr};
                gemm_phase(lds, S, E, 1024, 1024, 16);
            } PH_END
            ++nrm;
        }
        PH_BEGIN if (PHSEL(9)) {
            TileSched S; S.init(xb, wb + W_GU + (size_t)layer * 5767168, 1024, 1024, 256, 22);
            EpiF1 E{SSQ_CUR, H_b};
            gemm_phase(lds, S, E, 1024, 1024, 16);
            const float* pl = p.p + (size_t)layer * T * 256;
#pragma unroll 4
            for (size_t idx = gtid; idx < (size_t)T * 32; idx += gstride) { const f32x4 a = *(const f32x4*)(pl + idx * 8), b = *(const f32x4*)(pl + idx * 8 + 4);
                u32x4 w; w.x = cvt_pk_bf16(a[0], a[1]); w.y = cvt_pk_bf16(a[2], a[3]); w.z = cvt_pk_bf16(b[0], b[1]); w.w = cvt_pk_bf16(b[2], b[3]); *(u32x4*)(pb_b + idx * 8) = w; }
        } PH_END
        PH_BEGIN if (PHSEL(10)) {
            { TileSched S; S.init(H_b, wb + W_DN + (size_t)layer * 2883584, DFF, DFF, 256, 4);
              EpiResid<false> E{xb, xb, SSQ_NXT, nullptr, nullptr, 0, nullptr};
              gemm_phase(lds, S, E, DFF, DFF, 44); }
            { TileSched S; S.init(pb_b, wb + W_PP + (size_t)layer * 262144, 256, 256, 256, 4);
              EpiPlain<false> E{pp_b, 1024};
              gemm_phase(lds, S, E, 256, 256, 4); }
        } PH_END
        ++nrm;
        PH_BEGIN if (PHSEL(11)) {
            TileSched S; S.init(xb, wb + W_PG + (size_t)layer * 1048576, 1024, 1024, 256, 4);
            EpiResid<true> E{xb, xb_oth, SSQ_NXT, SSQ_CUR, pp_b, 0, layer == 3 ? outl : nullptr};
            gemm_phase(lds, S, E, 1024, 1024, 16);
        } PH_END
        ++nrm; xsel ^= 1;
    }
    PH_BEGIN if (PHSEL(12)) {
        const int lane = tidl & 63; const size_t gw = gtid >> 6, nw = gstride >> 6; const float* ssq = SSQ_CUR;
        for (size_t row = gw; row < (size_t)T; row += nw) {
            float s = lane < 16 ? ssq[row * 16 + lane] : 0.f;
#pragma unroll
            for (int o = 1; o < 16; o <<= 1) s += __shfl_xor(s, o);
            s = __shfl(s, 0);
            const float rs = rsqrtf(s * (1.f / 1024.f) + 1e-6f);
#pragma unroll
            for (int j = 0; j < 4; ++j) { const size_t off = row * 1024 + j * 256 + lane * 4; const f32x4 g = *(const f32x4*)(p.final_norm + j * 256 + lane * 4);
                f32x4 v = *(const f32x4*)(outl + off); v = v * rs * g; *(f32x4*)(outl + off) = v; }
        }
    } PH_END
}

constexpr int LDS_TOTAL = STAGE_BYTES + 32768;
constexpr int N_PHASES = 1 + 2 * (10 + 3) + 2 * (4 + 3) + 1;

extern "C" void kernel_launch(void* const* d_in, const int* in_sizes, int n_in, void* d_out, int out_size, void* d_ws, size_t ws_size, hipStream_t stream) {
    static int ready = 0;
    if (!ready) {
        if (hipFuncSetAttribute((const void*)fwd_kernel, hipFuncAttributeMaxDynamicSharedMemorySize, LDS_TOTAL) != hipSuccess) { fprintf(stderr, "hipFuncSetAttribute failed\n"); ready = -1; return; }
        if (ws_size < 1000 * MiB) { fprintf(stderr, "workspace too small: %zu\n", ws_size); ready = -1; return; }
        ready = 1;
    }
    if (ready < 0) return;
    Params p{};
    p.x = (const float*)d_in[0]; p.p = (const float*)d_in[1]; p.pos = (const int*)d_in[2]; p.norm_mix = (const float*)d_in[3]; p.ret_w_in = (const float*)d_in[4]; p.ret_w_out = (const float*)d_in[5];
    p.ret_gn = (const float*)d_in[6]; p.ret_decay = (const float*)d_in[7]; p.fno_w = (const float*)d_in[8]; p.norm_ffn = (const float*)d_in[9]; p.w_gate = (const float*)d_in[10]; p.w_up = (const float*)d_in[11];
    p.w_down = (const float*)d_in[12]; p.norm_ple = (const float*)d_in[13]; p.ple_wg = (const float*)d_in[14]; p.ple_wp = (const float*)d_in[15]; p.final_norm = (const float*)d_in[16];
    p.out = (float*)d_out; p.ws = (unsigned char*)d_ws;
#if COOP
    p.ph_lo = 0; p.ph_hi = N_PHASES;
    hipMemsetAsync((unsigned char*)d_ws + WS_BAR, 0, (XCD_BAR_WORDS + 2 * 256) * 4, stream);
    void* args[] = {&p};
    hipError_t e = hipLaunchCooperativeKernel((const void*)fwd_kernel, dim3(256), dim3(512), args, LDS_TOTAL, stream);
    if (e != hipSuccess) fprintf(stderr, "cooperative launch failed: %s\n", hipGetErrorString(e));
#else
    for (int ph = 0; ph < N_PHASES; ++ph) { p.ph_lo = ph; p.ph_hi = ph + 1; hipLaunchKernelGGL(fwd_kernel, dim3(256), dim3(512), LDS_TOTAL, stream, p); }
#endif
}
```

```cpp
#include <hip/hip_runtime.h>
#include <hip/hip_cooperative_groups.h>
#include <cstdio>
namespace cg = cooperative_groups;

#define LAS __attribute__((address_space(3)))
typedef unsigned short bf16_t;
typedef short bf16x8 __attribute__((ext_vector_type(8)));
typedef float f32x4 __attribute__((ext_vector_type(4)));
typedef float f32x2 __attribute__((ext_vector_type(2)));
typedef unsigned u32x4 __attribute__((ext_vector_type(4)));
typedef unsigned u32x2 __attribute__((ext_vector_type(2)));
typedef _Float16 h16x2 __attribute__((ext_vector_type(2)));

#ifndef COOP
#define COOP 1
#endif
#ifndef ONLY
#define ONLY -1
#endif
#define EX2(x) __builtin_amdgcn_exp2f(x)
#ifndef EXPDUP
#define EXPDUP -1
#endif
#define PHSEL(k) (ONLY < 0 || ONLY == (k))) for (int rep_ = 0; rep_ < ((EXPDUP) == (k) ? 2 : 1); ++rep_) if ((true)

constexpr int T = 65536, D = 1024, SEQ = 4096, DFF = 2816;
constexpr int TH = 32768;
constexpr size_t MiB = (size_t)1 << 20;
constexpr size_t WS_XB = 0;
constexpr size_t WS_W = 128 * MiB;
constexpr size_t WS_ROPE = 244 * MiB;
constexpr size_t WS_SSQ = 276 * MiB;
constexpr size_t WS_GST = 284 * MiB;
constexpr size_t WS_SCR = 292 * MiB;
constexpr size_t R_Q = 0, R_K = 64 * MiB, R_KTF = 128 * MiB, R_KTB = 192 * MiB, R_VTC = 256 * MiB, R_P = 384 * MiB, R_RF = 448 * MiB, R_RB = 576 * MiB;
constexpr size_t R_O = 64 * MiB;
constexpr size_t F_H = 0, F_PP = 352 * MiB, F_PB = 480 * MiB;
constexpr size_t Z_ZP = 0, Z_F = 256 * MiB, Z_D = 384 * MiB, Z_NY = 416 * MiB, Z_ST = 448 * MiB, Z_ZF = 576 * MiB;
constexpr size_t W_IN = 0;
constexpr size_t W_OUT = W_IN + 2 * 6291456;
constexpr size_t W_FNO = W_OUT + 2 * 2097152;
constexpr size_t W_DFT = W_FNO + 2 * 1048576;
constexpr size_t W_GU = W_DFT + 2 * 524288;
constexpr size_t W_DN = W_GU + 4 * 5767168;
constexpr size_t W_PG = W_DN + 4 * 2883584;
constexpr size_t W_PP = W_PG + 4 * 1048576;

struct Params {
    const float* x; const float* p; const int* pos; const float* norm_mix; const float* ret_w_in; const float* ret_w_out; const float* ret_gn; const float* ret_decay;
    const float* fno_w; const float* norm_ffn; const float* w_gate; const float* w_up; const float* w_down; const float* norm_ple; const float* ple_wg; const float* ple_wp; const float* final_norm;
    float* out; unsigned char* ws; int ph_lo, ph_hi;
};

__device__ __forceinline__ unsigned cvt_pk_bf16(float lo, float hi) { unsigned r; asm("v_cvt_pk_bf16_f32 %0, %1, %2" : "=v"(r) : "v"(lo), "v"(hi)); return r; }
__device__ __forceinline__ bf16_t f2bf(float f) { return (bf16_t)(cvt_pk_bf16(f, 0.f) & 0xffffu); }
__device__ __forceinline__ float bflo(unsigned w) { return __uint_as_float(w << 16); }
__device__ __forceinline__ float bfhi(unsigned w) { return __uint_as_float(w & 0xffff0000u); }
__device__ __forceinline__ float silu_f(float v) { return v * __builtin_amdgcn_rcpf(1.f + __expf(-v)); }
__device__ __forceinline__ float sigmoid_f(float v) { return __builtin_amdgcn_rcpf(1.f + __expf(-v)); }
__device__ __forceinline__ float lg2sig(float logit) { return -__log2f(1.f + __expf(-logit)); }
__device__ __forceinline__ float sum4(f32x4 v) { return (v[0] + v[1]) + (v[2] + v[3]); }
__device__ __forceinline__ float row_rstd(const float* ssq, int tok, int fq) {
    float s = sum4(*(const f32x4*)(ssq + (size_t)tok * 16 + fq * 4));
    s += __shfl_xor(s, 16); s += __shfl_xor(s, 32);
    return rsqrtf(s * (1.f / 1024.f) + 1e-6f);
}

struct PreNone { };
struct PreRs { float rs[8]; };
__device__ __forceinline__ void pre_rs(PreRs& P, const float* ssq, int row0, int wr, int fr, int fq) {
#pragma unroll
    for (int i = 0; i < 8; ++i) P.rs[i] = row_rstd(ssq, row0 + (i >> 2) * 128 + wr * 64 + (i & 3) * 16 + fr, fq);
#pragma unroll
    for (int i = 0; i < 8; ++i) asm volatile("" : "+v"(P.rs[i]));
}

constexpr int BM = 256, BK = 64, HALF = 128, HTB = HALF * BK * 2, STAGE_BYTES = 8 * HTB, NXCD = 8, WGM = 8;
__device__ __forceinline__ int lds_byte(int r, int c) { const int st = (r >> 4) * 2 + (c >> 5), rr = r & 15, cc = c & 31, ob = rr * 64 + cc * 2; return st * 1024 + (ob ^ (((ob >> 9) & 1) << 5)); }
__device__ __forceinline__ void stage_rc(int b, int& R, int& C) { const int st = b / 1024, sb = b % 1024, swz = sb ^ (((sb >> 9) & 1) << 5); R = (st >> 1) * 16 + swz / 64; C = (st & 1) * 32 + (swz % 64) / 2; }
__device__ __forceinline__ int perm32(int rho) { const int n = rho >> 4, i = rho & 15; return 8 * (i >> 2) + 4 * n + (i & 3); }
struct Unit { int pm, pn, z; };
__device__ __forceinline__ const char* uni(const char* p) { const unsigned long long v = (unsigned long long)p; const unsigned lo = __builtin_amdgcn_readfirstlane((unsigned)v), hi = __builtin_amdgcn_readfirstlane((unsigned)(v >> 32)); return (const char*)(((unsigned long long)hi << 32) | lo); }

template <class Epi, class Sched>
__device__ __forceinline__ void gemm_phase(LAS unsigned char* lds, const Sched& S, const Epi& E, const int lda, const int ldb, const int nt) {
    int tid = threadIdx.x; asm volatile("" : "+v"(tid));
    const int wid = __builtin_amdgcn_readfirstlane(tid >> 6), lane = tid & 63, wr = wid >> 2, wc = wid & 3, fr = lane & 15, fq = lane >> 4;
    unsigned voffA[2], voffB[2];
#pragma unroll
    for (int i = 0; i < 2; ++i) { int R, C; stage_rc(tid * 16 + i * 8192, R, C); const int Rb = Epi::PERM ? ((R & ~31) + perm32(R & 31)) : R;
        voffA[i] = (unsigned)(R * lda + C) * 2u; voffB[i] = (unsigned)(Rb * ldb + C) * 2u; }
    const size_t kstep = (size_t)(BK * 2);
    const size_t hstepA = (size_t)HALF * lda * 2, hstepB = (size_t)HALF * ldb * 2;
    const unsigned ldsbase = __builtin_amdgcn_readfirstlane((unsigned)(__UINTPTR_TYPE__)lds + (unsigned)wid * 1024u);
    const int aoff = lds_byte(wr * 64 + fr, fq * 8), boff = lds_byte(wc * 32 + fr, fq * 8);
#define G_SA(b, h) (((b) * 2 + (h)) * HTB)
#define G_SB(b, h) ((4 + (b) * 2 + (h)) * HTB)
#define G_STAGE(bufoff, gbase, voff) do { _Pragma("unroll") for (int _i = 0; _i < 2; ++_i) \
        asm volatile("s_mov_b32 m0, %0\n\ts_nop 0\n\tglobal_load_lds_dwordx4 %1, %2" :: "s"(ldsbase + (unsigned)((bufoff) + _i * 8192)), "v"((voff)[_i]), "s"((const char*)(gbase)) : "m0", "memory"); } while (0)
#define G_LDA(dst, b, h) do { _Pragma("unroll") for (int m = 0; m < 4; ++m) _Pragma("unroll") for (int k = 0; k < 2; ++k) dst[m][k] = *(const LAS bf16x8*)(lds + G_SA(b, h) + aoff + m * 2048 + k * 1024); } while (0)
#define G_LDB(dst, b, h) do { _Pragma("unroll") for (int n = 0; n < 2; ++n) _Pragma("unroll") for (int k = 0; k < 2; ++k) dst[n][k] = *(const LAS bf16x8*)(lds + G_SB(b, h) + boff + n * 2048 + k * 1024); } while (0)
#define G_MMA(ai, bj, At, Bt) do { __builtin_amdgcn_s_setprio(1); _Pragma("unroll") for (int m = 0; m < 4; ++m) _Pragma("unroll") for (int n = 0; n < 2; ++n) _Pragma("unroll") for (int k = 0; k < 2; ++k) \
        acc[ai][bj][m][n] = __builtin_amdgcn_mfma_f32_16x16x32_bf16(Bt[n][k], At[m][k], acc[ai][bj][m][n], 0, 0, 0); __builtin_amdgcn_s_setprio(0); } while (0)
#define G_WAIT_V(n) asm volatile("s_waitcnt vmcnt(" #n ")" ::: "memory")
#define G_WAIT_L(n) asm volatile("s_waitcnt lgkmcnt(" #n ")" ::: "memory")
#define G_BAR __builtin_amdgcn_s_barrier()
#define G_SCHED __builtin_amdgcn_sched_barrier(0)
    Unit cur, nxt; int ui = 0;
    if (!S.next(0, cur)) return;
    f32x4 acc[2][2][4][2];
#pragma unroll
    for (int a = 0; a < 2; ++a)
#pragma unroll
        for (int b = 0; b < 2; ++b)
#pragma unroll
            for (int m = 0; m < 4; ++m)
#pragma unroll
                for (int n = 0; n < 2; ++n) acc[a][b][m][n] = (f32x4){0.f, 0.f, 0.f, 0.f};
    bf16x8 At[4][2], B0[2][2], B1[2][2];
    const char* cA; const char* cB; S.ptrs(cur, cA, cB); cA = uni(cA); cB = uni(cB);
    typename Epi::Pre pre; E.pre_load(cur, wr, fr, fq, pre);
    G_STAGE(G_SB(0, 0), cB, voffB); G_STAGE(G_SA(0, 0), cA, voffA); G_STAGE(G_SB(0, 1), uni(cB + hstepB), voffB); G_STAGE(G_SA(0, 1), uni(cA + hstepA), voffA);
    if (wr == 1) G_BAR;
    G_WAIT_V(4); G_BAR;
    G_STAGE(G_SB(1, 0), uni(cB + kstep), voffB); G_STAGE(G_SA(1, 0), uni(cA + kstep), voffA); G_STAGE(G_SB(1, 1), uni(cB + hstepB + kstep), voffB);
    G_WAIT_V(6); G_BAR;
    for (;;) {
        const bool has_next = S.next(ui + 1, nxt);
        const char* nA = cA; const char* nB = cB; if (has_next) { S.ptrs(nxt, nA, nB); nA = uni(nA); nB = uni(nB); }
        for (int t = 0; t < nt; t += 2) {
            const bool last = (t == nt - 2);
            const char* a1 = uni(cA + (size_t)(t + 1) * kstep);
            const char* a2 = uni(last ? nA : cA + (size_t)(t + 2) * kstep); const char* b2 = uni(last ? nB : cB + (size_t)(t + 2) * kstep);
            const char* a3 = uni(a2 + kstep); const char* b3 = uni(b2 + kstep);
            const char* a1h = uni(a1 + hstepA); const char* a2h = uni(a2 + hstepA); const char* b2h = uni(b2 + hstepB); const char* b3h = uni(b3 + hstepB);
            G_LDB(B0, 0, 0); G_SCHED; G_LDA(At, 0, 0); G_STAGE(G_SA(1, 1), a1h, voffA);
            G_WAIT_L(8); G_BAR; G_WAIT_L(0); G_MMA(0, 0, At, B0); G_BAR; G_SCHED;
            G_LDB(B1, 0, 1); G_STAGE(G_SB(0, 0), b2, voffB);
            G_BAR; G_WAIT_L(0); G_MMA(0, 1, At, B1); G_BAR;
            G_LDA(At, 0, 1); G_STAGE(G_SA(0, 0), a2, voffA);
            G_BAR; G_WAIT_L(0); G_MMA(1, 0, At, B0); G_BAR; G_SCHED;
            G_STAGE(G_SB(0, 1), b2h, voffB);
            G_WAIT_V(6); G_BAR; G_MMA(1, 1, At, B1); G_BAR;
            G_LDB(B0, 1, 0); G_SCHED; G_LDA(At, 1, 0); G_STAGE(G_SA(0, 1), a2h, voffA);
            G_WAIT_L(8); G_BAR; G_WAIT_L(0); G_MMA(0, 0, At, B0); G_BAR; G_SCHED;
            G_LDB(B1, 1, 1); G_STAGE(G_SB(1, 0), b3, voffB);
            G_BAR; G_WAIT_L(0); G_MMA(0, 1, At, B1); G_BAR;
            G_LDA(At, 1, 1); G_STAGE(G_SA(1, 0), a3, voffA);
            G_BAR; G_WAIT_L(0); G_MMA(1, 0, At, B0); G_BAR; G_SCHED;
            G_STAGE(G_SB(1, 1), b3h, voffB);
            G_WAIT_V(6); G_BAR; G_MMA(1, 1, At, B1); G_BAR;
        }
        { int fr_o = fr, fq_o = fq; asm volatile("" : "+v"(fr_o), "+v"(fq_o)); E(acc, cur, wr, wc, fr_o, fq_o, pre); }
        if (!has_next) break;
        if (!Epi::KEEP) {
#pragma unroll
            for (int a = 0; a < 2; ++a)
#pragma unroll
                for (int b = 0; b < 2; ++b)
#pragma unroll
                    for (int m = 0; m < 4; ++m)
#pragma unroll
                        for (int n = 0; n < 2; ++n) acc[a][b][m][n] = (f32x4){0.f, 0.f, 0.f, 0.f};
        }
        cur = nxt; cA = nA; cB = nB; ++ui;
        E.pre_load(cur, wr, fr, fq, pre);
    }
    G_WAIT_V(0);
    if (wr == 0) G_BAR;
    G_BAR;
#undef G_SA
#undef G_SB
#undef G_STAGE
#undef G_LDA
#undef G_LDB
#undef G_MMA
#undef G_WAIT_V
#undef G_WAIT_L
#undef G_BAR
#undef G_SCHED
}

struct TileSched {
    const char* A; const char* B; size_t sA, sB; int nM, nN, nwg, G, c;
    __device__ __forceinline__ void init(const void* A_, const void* B_, int lda, int ldb, int nM_, int nN_) {
        A = (const char*)A_; B = (const char*)B_; sA = (size_t)BM * lda * 2; sB = (size_t)BM * ldb * 2; nM = nM_; nN = nN_; nwg = nM * nN; G = gridDim.x; c = blockIdx.x; }
    __device__ __forceinline__ bool next(int i, Unit& u) const {
        const long L = (long)i * G + c; if (L >= nwg) return false;
        int wgid = (int)L; { const int q = nwg / NXCD, r = nwg % NXCD, xcd = wgid % NXCD, off = wgid / NXCD; wgid = (xcd < r ? xcd * (q + 1) : r * (q + 1) + (xcd - r) * q) + off; }
        const int nig = WGM * nN, gid = wgid / nig, fm = gid * WGM, gsz = (nM - fm) < WGM ? (nM - fm) : WGM;
        u.pm = fm + ((wgid % nig) % gsz); u.pn = (wgid % nig) / gsz; u.z = 0; return true;
    }
    __device__ __forceinline__ void ptrs(const Unit& u, const char*& a, const char*& b) const { a = A + (size_t)u.pm * sA; b = B + (size_t)u.pn * sB; }
};
struct Z1Sched {
    const char* W; const char* X; int G, c;
    __device__ __forceinline__ bool next(int i, Unit& u) const { if (i * G + c >= 2048) return false; const int x = c & 7, y = c >> 3; u.pm = ((x & 3) << 1) | (y & 1); u.pn = i * (G >> 3) + (x >> 2) + 2 * (y >> 1); u.z = 0; return true; }
    __device__ __forceinline__ void ptrs(const Unit& u, const char*& a, const char*& b) const { a = W + (size_t)u.pm * (256 * 256 * 2); b = X + (size_t)u.pn * (256 * 1024 * 2) + (size_t)(u.pm >> 1) * 512; }
};
struct ScanSched {
    const char* vtc; const char* kt; int dir; bool active;
    __device__ __forceinline__ bool next(int i, Unit& u) const { if (!active || i >= 16) return false; u.z = i; u.pm = dir ? 15 - i : i; u.pn = 0; return true; }
    __device__ __forceinline__ void ptrs(const Unit& u, const char*& a, const char*& b) const { a = vtc + (size_t)u.pm * (131072 * 2); b = kt + (size_t)u.pm * (65536 * 2); }
};
struct ScoreSched {
    const char* q; const char* k; int c, stride;
    __device__ __forceinline__ bool next(int i, Unit& u) const { if (c < 0) return false; const int L = i * stride + c; if (L >= 512) return false; u.pm = L; u.pn = 0; u.z = 0; return true; }
    __device__ __forceinline__ void ptrs(const Unit& u, const char*& a, const char*& b) const { a = q + (size_t)u.pm * (65536 * 2); b = k + (size_t)u.pm * (65536 * 2); }
};
struct OutSched {
    const char* scr; int G, c;
    __device__ __forceinline__ bool next(int i, Unit& u) const { const int k = i / 3; if (k * G + c >= 1024) return false; u.pn = (c >> 3) & 1; u.pm = k * (G >> 1) + (c & 7) + 8 * (c >> 4); u.z = i - k * 3; return true; }
    __device__ __forceinline__ void ptrs(const Unit& u, const char*& a, const char*& b) const {
        const size_t ro = ((size_t)u.pm * 512 + (size_t)u.pn * 256) * 256 * 2;
        const size_t z1 = (size_t)(u.z == 1), z2 = (size_t)(u.z == 2);
        a = scr + R_Q + z2 * (R_P - R_Q) + (size_t)u.pm * (65536 * 2);
        b = scr + R_RB - z1 * (R_RB - R_RF) - z2 * (R_RB - R_VTC) + ro; }
};

__device__ __forceinline__ void tr_write8(LAS unsigned char* tw, int r, int fq, const u32x4 w) {
#pragma unroll
    for (int i = 0; i < 8; ++i) { const unsigned v = w[i >> 1];
        *(LAS unsigned short*)(tw + (fq * 8 + i) * 128 + ((((r >> 3) ^ ((i ^ fq) & 7))) << 4) + (r & 7) * 2) = (unsigned short)((i & 1) ? (v >> 16) : (v & 0xffffu)); }
}
struct EpiR1 {
    typedef PreRs Pre;
    __device__ __forceinline__ void pre_load(const Unit& u, int wr, int fr, int fq, Pre& P) const { pre_rs(P, ssq, tok0 + u.pm * 256, wr, fr, fq); }
    static constexpr bool PERM = true, KEEP = false;
    const float* ssq; const unsigned* rope; const float* decay; bf16_t* q; bf16_t* k; bf16_t* ktf; bf16_t* ktb; bf16_t* vtc; int tok0; LAS unsigned char* tl;
    __device__ __forceinline__ void operator()(f32x4 (&acc)[2][2][4][2], const Unit& u, int wr, int wc, int fr, int fq, const Pre& pre) const {
        const int bl = u.pm >> 4, chunk = u.pm & 15, cbase = wc * 32 + fq * 8;
        LAS unsigned char* tw = tl + (wr * 4 + wc) * 4096;
        const int lane = fq * 16 + fr, tc = lane >> 3, jg = lane & 7;
        const float (&rsv)[8] = pre.rs;
        if (u.pn < 8) {
            const bool isk = u.pn >= 4; const int h = u.pn & 3;
            const float lgf = lg2sig(decay[h]), lgb = lg2sig(decay[4 + h]);
            bf16_t* dst = (isk ? k : q) + ((size_t)(bl * 4 + h) * 4096 + chunk * 256) * 256;
            const size_t tb = ((size_t)(bl * 4 + h) * 16 + chunk) * 65536;
#pragma unroll
            for (int ai = 0; ai < 2; ++ai) {
                u32x4 w2s[4];
#pragma unroll
                for (int m = 0; m < 4; ++m) {
                    if (m == 0) asm volatile("" ::: "memory");
                    const int j = ai * 128 + wr * 64 + m * 16 + fr; const int tok = tok0 + u.pm * 256 + j;
                    const float rs = rsv[ai * 4 + m];
                    const u32x4 r0 = *(const u32x4*)(rope + (size_t)tok * 128 + cbase), r1 = *(const u32x4*)(rope + (size_t)tok * 128 + cbase + 4);
                    float o1[8], o2[8];
#pragma unroll
                    for (int n = 0; n < 2; ++n)
#pragma unroll
                        for (int jj = 0; jj < 4; ++jj) {
                            const h16x2 cs = __builtin_bit_cast(h16x2, n == 0 ? r0[jj] : r1[jj]); const float c = (float)cs.x, s = (float)cs.y;
                            const float x1 = acc[ai][0][m][n][jj] * rs, x2 = acc[ai][1][m][n][jj] * rs;
                            o1[n * 4 + jj] = x1 * c - x2 * s; o2[n * 4 + jj] = x1 * s + x2 * c; }
                    u32x4 w1, w2;
                    w1.x = cvt_pk_bf16(o1[0], o1[1]); w1.y = cvt_pk_bf16(o1[2], o1[3]); w1.z = cvt_pk_bf16(o1[4], o1[5]); w1.w = cvt_pk_bf16(o1[6], o1[7]);
                    w2.x = cvt_pk_bf16(o2[0], o2[1]); w2.y = cvt_pk_bf16(o2[2], o2[3]); w2.z = cvt_pk_bf16(o2[4], o2[5]); w2.w = cvt_pk_bf16(o2[6], o2[7]);
                    *(u32x4*)(dst + (size_t)j * 256 + cbase) = w1; *(u32x4*)(dst + (size_t)j * 256 + cbase + 128) = w2;
                    if (isk) { tr_write8(tw, m * 16 + fr, fq, w1); w2s[m] = w2; }
                }
                if (isk) {
                    const int jb = ai * 128 + wr * 64 + jg * 8;
                    float zf[8], zb[8];
#pragma unroll
                    for (int i = 0; i < 8; ++i) { zf[i] = EX2(lgf * (float)(255 - jb - i)); zb[i] = EX2(lgb * (float)(jb + i)); }
#pragma unroll
                    for (int grp = 0; grp < 2; ++grp) {
                        if (grp == 1) {
#pragma unroll
                            for (int m = 0; m < 4; ++m) tr_write8(tw, m * 16 + fr, fq, w2s[m]);
                        }
#pragma unroll
                        for (int ps = 0; ps < 4; ++ps) {
                            const int c = ps * 8 + tc; const u32x4 rd = *(const LAS u32x4*)(tw + c * 128 + ((jg ^ ((tc ^ ps) & 7)) << 4));
                            const size_t e = tb + (size_t)(wc * 32 + grp * 128 + c) * 256 + jb;
                            u32x4 a, b;
#pragma unroll
                            for (int t = 0; t < 4; ++t) { const float lo = bflo(rd[t]), hi = bfhi(rd[t]);
                                a[t] = cvt_pk_bf16(lo * zf[2 * t], hi * zf[2 * t + 1]); b[t] = cvt_pk_bf16(lo * zb[2 * t], hi * zb[2 * t + 1]); }
                            __builtin_nontemporal_store(a, (u32x4*)(ktf + e)); __builtin_nontemporal_store(b, (u32x4*)(ktb + e)); }
                    }
                }
            }
        } else {
            const int h = (u.pn - 8) >> 1, eh = ((u.pn - 8) & 1) * 256;
            const size_t tb = ((size_t)(bl * 4 + h) * 16 + chunk) * 131072;
#pragma unroll
            for (int ai = 0; ai < 2; ++ai)
#pragma unroll
                for (int bj = 0; bj < 2; ++bj) {
#pragma unroll
                    for (int m = 0; m < 4; ++m) { const float rs = rsv[ai * 4 + m]; const f32x4 v0 = acc[ai][bj][m][0] * rs, v1 = acc[ai][bj][m][1] * rs;
                        u32x4 w; w.x = cvt_pk_bf16(v0[0], v0[1]); w.y = cvt_pk_bf16(v0[2], v0[3]); w.z = cvt_pk_bf16(v1[0], v1[1]); w.w = cvt_pk_bf16(v1[2], v1[3]);
                        tr_write8(tw, m * 16 + fr, fq, w); }
#pragma unroll
                    for (int ps = 0; ps < 4; ++ps) {
                        const int c = ps * 8 + tc; const u32x4 rd = *(const LAS u32x4*)(tw + c * 128 + ((jg ^ ((tc ^ ps) & 7)) << 4));
                        __builtin_nontemporal_store(rd, (u32x4*)(vtc + tb + (size_t)(eh + bj * 128 + wc * 32 + c) * 256 + ai * 128 + wr * 64 + jg * 8)); }
                }
        }
    }
};
struct EpiScore {
    typedef PreNone Pre;
    __device__ __forceinline__ void pre_load(const Unit& u, int wr, int fr, int fq, Pre& P) const {  }
    static constexpr bool PERM = true, KEEP = false;
    const float* decay; bf16_t* P;
    __device__ __forceinline__ void operator()(f32x4 (&acc)[2][2][4][2], const Unit& u, int wr, int wc, int fr, int fq, const Pre& pre) const {
        const int h = (u.pm >> 4) & 3; const float lgf = lg2sig(decay[h]), lgb = lg2sig(decay[4 + h]);
        bf16_t* dst = P + (size_t)u.pm * 65536;
#pragma unroll
        for (int ai = 0; ai < 2; ++ai)
#pragma unroll
            for (int m = 0; m < 4; ++m) {
                const int a = ai * 128 + wr * 64 + m * 16 + fr;
#pragma unroll
                for (int bj = 0; bj < 2; ++bj) {
                    const int b0 = bj * 128 + wc * 32 + fq * 8; float v[8];
#pragma unroll
                    for (int n = 0; n < 2; ++n)
#pragma unroll
                        for (int jj = 0; jj < 4; ++jj) { const float df = (float)(a - (b0 + n * 4 + jj)); const float dm = EX2(lgf * fmaxf(df, 0.f) + lgb * fmaxf(-df, 0.f)); v[n * 4 + jj] = acc[ai][bj][m][n][jj] * dm; }
                    u32x4 w; w.x = cvt_pk_bf16(v[0], v[1]); w.y = cvt_pk_bf16(v[2], v[3]); w.z = cvt_pk_bf16(v[4], v[5]); w.w = cvt_pk_bf16(v[6], v[7]);
                    *(u32x4*)(dst + (size_t)a * 256 + b0) = w; }
            }
    }
};
struct EpiScan {
    typedef PreNone Pre;
    __device__ __forceinline__ void pre_load(const Unit& u, int wr, int fr, int fq, Pre& P) const {  }
    static constexpr bool PERM = true, KEEP = true;
    bf16_t* rt; int dir; const float* dptr;
    __device__ __forceinline__ void operator()(f32x4 (&acc)[2][2][4][2], const Unit& u, int wr, int wc, int fr, int fq, const Pre& pre) const {
        const float g = EX2(256.f * lg2sig(*dptr));
        const int target = dir ? u.pm - 1 : u.pm + 1;
        if (target >= 0 && target < 16) {
            bf16_t* dst = rt + (size_t)target * 131072;
#pragma unroll
            for (int ai = 0; ai < 2; ++ai)
#pragma unroll
                for (int m = 0; m < 4; ++m) {
                    const int e = ai * 128 + wr * 64 + m * 16 + fr;
#pragma unroll
                    for (int bj = 0; bj < 2; ++bj) { const f32x4 v0 = acc[ai][bj][m][0], v1 = acc[ai][bj][m][1];
                        u32x4 w; w.x = cvt_pk_bf16(v0[0], v0[1]); w.y = cvt_pk_bf16(v0[2], v0[3]); w.z = cvt_pk_bf16(v1[0], v1[1]); w.w = cvt_pk_bf16(v1[2], v1[3]);
                        __builtin_nontemporal_store(w, (u32x4*)(dst + (size_t)e * 256 + bj * 128 + wc * 32 + fq * 8)); }
                }
        }
#pragma unroll
        for (int ai = 0; ai < 2; ++ai)
#pragma unroll
            for (int bj = 0; bj < 2; ++bj)
#pragma unroll
                for (int m = 0; m < 4; ++m)
#pragma unroll
                    for (int n = 0; n < 2; ++n) acc[ai][bj][m][n] *= g;
    }
};
struct EpiOut {
    typedef PreNone Pre;
    __device__ __forceinline__ void pre_load(const Unit& u, int wr, int fr, int fq, Pre& P) const {  }
    static constexpr bool PERM = true, KEEP = true;
    const float* decay; bf16_t* o; float* gst;
    __device__ __forceinline__ void operator()(f32x4 (&acc)[2][2][4][2], const Unit& u, int wr, int wc, int fr, int fq, const Pre& pre) const {
        const int bh = u.pm >> 4, chunk = u.pm & 15, h = bh & 3, bl = bh >> 2;
        const float lgf = lg2sig(decay[h]), lgb = lg2sig(decay[4 + h]);
        const float kf = u.z == 0 ? -lgf : (u.z == 1 ? lgf : 0.f), kb = u.z == 0 ? lgb : 0.f, kz = u.z == 2 ? 0.f : 1.f;
#pragma unroll
        for (int ai = 0; ai < 2; ++ai)
#pragma unroll
            for (int m = 0; m < 4; ++m) {
                const int a = ai * 128 + wr * 64 + m * 16 + fr;
                if (u.z == 2) {
                    const int tl = bl * 4096 + chunk * 256 + a;
                    float s1 = 0.f, s2 = 0.f;
#pragma unroll
                    for (int bj = 0; bj < 2; ++bj) { const f32x4 v0 = acc[ai][bj][m][0], v1 = acc[ai][bj][m][1];
                        s1 += sum4(v0) + sum4(v1); s2 += sum4(v0 * v0) + sum4(v1 * v1);
                        u32x4 w; w.x = cvt_pk_bf16(v0[0], v0[1]); w.y = cvt_pk_bf16(v0[2], v0[3]); w.z = cvt_pk_bf16(v1[0], v1[1]); w.w = cvt_pk_bf16(v1[2], v1[3]);
                        __builtin_nontemporal_store(w, (u32x4*)(o + (size_t)tl * 2048 + h * 512 + u.pn * 256 + bj * 128 + wc * 32 + fq * 8)); }
                    s1 += __shfl_xor(s1, 16); s1 += __shfl_xor(s1, 32); s2 += __shfl_xor(s2, 16); s2 += __shfl_xor(s2, 32);
                    if (fq == 0) *(f32x2*)(gst + (((size_t)tl * 4 + h) * 8 + u.pn * 4 + wc) * 2) = (f32x2){s1, s2};
                }
                const float sc = kz * EX2(kf * (float)(a + 1) + kb * (float)(256 - a));
#pragma unroll
                for (int bj = 0; bj < 2; ++bj)
#pragma unroll
                    for (int n = 0; n < 2; ++n) acc[ai][bj][m][n] *= sc;
                asm volatile("" ::: "memory");
            }
    }
};
struct EpiGate {
    typedef PreRs Pre;
    __device__ __forceinline__ void pre_load(const Unit& u, int wr, int fr, int fq, Pre& P) const { pre_rs(P, ssq, tok0 + u.pm * 256, wr, fr, fq); }
    static constexpr bool PERM = true, KEEP = false;
    const float* ssq; const float* gst; const float* gng; bf16_t* o; int tok0;
    __device__ __forceinline__ void operator()(f32x4 (&acc)[2][2][4][2], const Unit& u, int wr, int wc, int fr, int fq, const Pre& pre) const {
        const int h = u.pn >> 1, c0 = u.pn * 256 + wc * 32 + fq * 8;
        f32x4 gg[2][2];
#pragma unroll
        for (int bj = 0; bj < 2; ++bj) { gg[bj][0] = *(const f32x4*)(gng + c0 + bj * 128); gg[bj][1] = *(const f32x4*)(gng + c0 + bj * 128 + 4); }
        float rsv[8], muv[8], grv[8];
#pragma unroll
        for (int i = 0; i < 8; ++i) {
            const int tl = u.pm * 256 + (i >> 2) * 128 + wr * 64 + (i & 3) * 16 + fr;
            rsv[i] = pre.rs[i];
            const f32x4 st = *(const f32x4*)(gst + ((size_t)tl * 4 + h) * 16 + fq * 4);
            float s1 = st[0] + st[2], s2 = st[1] + st[3];
            s1 += __shfl_xor(s1, 16); s1 += __shfl_xor(s1, 32); s2 += __shfl_xor(s2, 16); s2 += __shfl_xor(s2, 32);
            muv[i] = s1 * (1.f / 512.f); grv[i] = rsqrtf(fmaxf(s2 * (1.f / 512.f) - muv[i] * muv[i], 0.f) + 1e-6f); }
#pragma unroll
        for (int ai = 0; ai < 2; ++ai)
#pragma unroll
            for (int m = 0; m < 4; ++m) {
                const int tl = u.pm * 256 + ai * 128 + wr * 64 + m * 16 + fr;
                if (m == 0) asm volatile("" ::: "memory");
                const float rs = rsv[ai * 4 + m], mu = muv[ai * 4 + m], gr = grv[ai * 4 + m];
#pragma unroll
                for (int bj = 0; bj < 2; ++bj) {
                    bf16_t* op = o + (size_t)tl * 2048 + c0 + bj * 128;
                    const u32x4 ov = *(const u32x4*)op; float y[8];
#pragma unroll
                    for (int n = 0; n < 2; ++n)
#pragma unroll
                        for (int jj = 0; jj < 4; ++jj) { const unsigned w = ov[n * 2 + (jj >> 1)]; const float oval = (jj & 1) ? bfhi(w) : bflo(w);
                            y[n * 4 + jj] = silu_f(acc[ai][bj][m][n][jj] * rs) * gg[bj][n][jj] * (oval - mu) * gr; }
                    u32x4 w; w.x = cvt_pk_bf16(y[0], y[1]); w.y = cvt_pk_bf16(y[2], y[3]); w.z = cvt_pk_bf16(y[4], y[5]); w.w = cvt_pk_bf16(y[6], y[7]);
                    *(u32x4*)op = w; }
            }
    }
};
template <bool GATED> struct EpiResid {
    static constexpr bool PERM = true, KEEP = false;
    typedef PreRs Pre;
    __device__ __forceinline__ void pre_load(const Unit& u, int wr, int fr, int fq, Pre& P) const { if (GATED) pre_rs(P, ssq_in, tok0 + u.pm * 256, wr, fr, fq); }
    const bf16_t* xin; bf16_t* xout; float* ssq_out; const float* ssq_in; const bf16_t* pp; int tok0; float* xf32;
    __device__ __forceinline__ void operator()(f32x4 (&acc)[2][2][4][2], const Unit& u, int wr, int wc, int fr, int fq, const Pre& pre) const {
        const int c0 = u.pn * 256 + wc * 32 + fq * 8;
#pragma unroll
        for (int ai = 0; ai < 2; ++ai) {
            u32x4 pv[4][2];
            if (GATED) {
#pragma unroll
                for (int m = 0; m < 4; ++m)
#pragma unroll
                    for (int bj = 0; bj < 2; ++bj) pv[m][bj] = *(const u32x4*)(pp + (size_t)(tok0 + u.pm * 256 + ai * 128 + wr * 64 + m * 16 + fr) * 1024 + c0 + bj * 128);
            }
#pragma unroll
            for (int m = 0; m < 4; ++m) {
                const int tok = tok0 + u.pm * 256 + ai * 128 + wr * 64 + m * 16 + fr;
                const float nrl = GATED ? -1.4426950408889634f * pre.rs[ai * 4 + m] : 0.f;
                f32x4 ssv = (f32x4){0.f, 0.f, 0.f, 0.f};
#pragma unroll
                for (int bj = 0; bj < 2; ++bj) {
                    const size_t off = (size_t)tok * 1024 + c0 + bj * 128;
                    const u32x4 xv = *(const u32x4*)(xin + off);
                    f32x4 v0 = (f32x4){bflo(xv.x), bfhi(xv.x), bflo(xv.y), bfhi(xv.y)}, v1 = (f32x4){bflo(xv.z), bfhi(xv.z), bflo(xv.w), bfhi(xv.w)};
                    if (GATED) {
                        const u32x4 pw = pv[m][bj];
                        const f32x4 p0 = (f32x4){bflo(pw.x), bfhi(pw.x), bflo(pw.y), bfhi(pw.y)}, p1 = (f32x4){bflo(pw.z), bfhi(pw.z), bflo(pw.w), bfhi(pw.w)};
                        const f32x4 t0 = acc[ai][bj][m][0] * nrl, t1 = acc[ai][bj][m][1] * nrl;
                        f32x4 e0, e1; e0[0] = EX2(t0[0]); e0[1] = EX2(t0[1]); e0[2] = EX2(t0[2]); e0[3] = EX2(t0[3]); e1[0] = EX2(t1[0]); e1[1] = EX2(t1[1]); e1[2] = EX2(t1[2]); e1[3] = EX2(t1[3]);
                        const f32x4 d0 = e0 + 1.0f, d1 = e1 + 1.0f;
                        f32x4 r0, r1; r0[0] = __builtin_amdgcn_rcpf(d0[0]); r0[1] = __builtin_amdgcn_rcpf(d0[1]); r0[2] = __builtin_amdgcn_rcpf(d0[2]); r0[3] = __builtin_amdgcn_rcpf(d0[3]);
                        r1[0] = __builtin_amdgcn_rcpf(d1[0]); r1[1] = __builtin_amdgcn_rcpf(d1[1]); r1[2] = __builtin_amdgcn_rcpf(d1[2]); r1[3] = __builtin_amdgcn_rcpf(d1[3]);
                        v0 += r0 * p0; v1 += r1 * p1; }
                    else { v0 += acc[ai][bj][m][0]; v1 += acc[ai][bj][m][1]; }
                    ssv += v0 * v0; ssv += v1 * v1;
                    if (GATED && xf32) { *(f32x4*)(xf32 + off) = v0; *(f32x4*)(xf32 + off + 4) = v1; }
                    else { u32x4 w; w.x = cvt_pk_bf16(v0[0], v0[1]); w.y = cvt_pk_bf16(v0[2], v0[3]); w.z = cvt_pk_bf16(v1[0], v1[1]); w.w = cvt_pk_bf16(v1[2], v1[3]); *(u32x4*)(xout + off) = w; } }
                float ss = sum4(ssv);
                ss += __shfl_xor(ss, 16); ss += __shfl_xor(ss, 32);
                if (fq == 0) ssq_out[(size_t)tok * 16 + u.pn * 4 + wc] = ss;
            }
            asm volatile("" ::: "memory");
        }
    }
};
struct EpiF1 {
    typedef PreRs Pre;
    __device__ __forceinline__ void pre_load(const Unit& u, int wr, int fr, int fq, Pre& P) const { pre_rs(P, ssq, u.pm * 256, wr, fr, fq); }
    static constexpr bool PERM = true, KEEP = false;
    const float* ssq; bf16_t* H;
    __device__ __forceinline__ void operator()(f32x4 (&acc)[2][2][4][2], const Unit& u, int wr, int wc, int fr, int fq, const Pre& pre) const {
#pragma unroll
        for (int ai = 0; ai < 2; ++ai)
#pragma unroll
            for (int m = 0; m < 4; ++m) {
                const int tok = u.pm * 256 + ai * 128 + wr * 64 + m * 16 + fr;
                const float rs = pre.rs[ai * 4 + m]; const float nrl = -1.4426950408889634f * rs, rs2 = rs * rs; f32x4 hv[2];
#pragma unroll
                for (int n = 0; n < 2; ++n) {
                    const f32x4 g4 = acc[ai][0][m][n], u4 = acc[ai][1][m][n]; const f32x4 t4 = g4 * nrl;
                    f32x4 e4; e4[0] = EX2(t4[0]); e4[1] = EX2(t4[1]); e4[2] = EX2(t4[2]); e4[3] = EX2(t4[3]);
                    const f32x4 d4 = e4 + 1.0f;
                    f32x4 r4; r4[0] = __builtin_amdgcn_rcpf(d4[0]); r4[1] = __builtin_amdgcn_rcpf(d4[1]); r4[2] = __builtin_amdgcn_rcpf(d4[2]); r4[3] = __builtin_amdgcn_rcpf(d4[3]);
                    hv[n] = (g4 * u4) * (r4 * rs2); }
                u32x4 w; w.x = cvt_pk_bf16(hv[0][0], hv[0][1]); w.y = cvt_pk_bf16(hv[0][2], hv[0][3]); w.z = cvt_pk_bf16(hv[1][0], hv[1][1]); w.w = cvt_pk_bf16(hv[1][2], hv[1][3]);
                __builtin_nontemporal_store(w, (u32x4*)(H + (size_t)tok * DFF + u.pn * 128 + wc * 32 + fq * 8));
            }
    }
};
template <bool ZMAP> struct EpiPlain {
    typedef PreNone Pre;
    __device__ __forceinline__ void pre_load(const Unit& u, int wr, int fr, int fq, Pre& P) const {  }
    static constexpr bool PERM = true, KEEP = false;
    bf16_t* C; int ldc;
    __device__ __forceinline__ void operator()(f32x4 (&acc)[2][2][4][2], const Unit& u, int wr, int wc, int fr, int fq, const Pre& pre) const {
#pragma unroll
        for (int ai = 0; ai < 2; ++ai)
#pragma unroll
            for (int m = 0; m < 4; ++m) {
                const int r = u.pm * 256 + ai * 128 + wr * 64 + m * 16 + fr;
                bf16_t* rowp = ZMAP ? C + ((size_t)(u.pn >> 2) * 4096 + r) * 1024 + (u.pn & 3) * 256 : C + (size_t)r * ldc + u.pn * 256;
#pragma unroll
                for (int bj = 0; bj < 2; ++bj) { const f32x4 v0 = acc[ai][bj][m][0], v1 = acc[ai][bj][m][1];
                    u32x4 w; w.x = cvt_pk_bf16(v0[0], v0[1]); w.y = cvt_pk_bf16(v0[2], v0[3]); w.z = cvt_pk_bf16(v1[0], v1[1]); w.w = cvt_pk_bf16(v1[2], v1[3]);
                    *(u32x4*)(rowp + bj * 128 + wc * 32 + fq * 8) = w; }
            }
    }
};
struct Z2Sched {
    const char* D; const char* Z; int G, c;
    __device__ __forceinline__ bool next(int i, Unit& u) const { const int r = i >> 1; if (r * G + c >= 512) return false; const int x = c & 7, y = c >> 3; u.pm = y & 7; u.pn = r * (G >> 3) + x * 4 + (y >> 3); u.z = (i & 1) | (r << 1); return true; }
    __device__ __forceinline__ void ptrs(const Unit& u, const char*& a, const char*& b) const {
        const size_t so = (size_t)(u.z & 1) * 4096;
        a = D + (size_t)u.pm * (256 * 4096 * 2) + so; b = Z + (size_t)u.pn * (256 * 4096 * 2) + so; }
};
struct EpiZ2 {
    typedef PreNone Pre;
    __device__ __forceinline__ void pre_load(const Unit& u, int wr, int fr, int fq, Pre& P) const {  }
    static constexpr bool PERM = true, KEEP = true;
    bf16_t* Fo; float* stash; const bf16_t* nyq;
    __device__ __forceinline__ void operator()(f32x4 (&acc)[2][2][4][2], const Unit& u, int wr, int wc, int fr, int fq, const Pre& pre) const {
        const int tid = (wr * 4 + wc) * 64 + fq * 16 + fr;
        float* st = stash + (size_t)(u.z >> 1) * 65536 + (size_t)tid * 4;
        if ((u.z & 1) == 0) {
#pragma unroll
            for (int ai = 0; ai < 2; ++ai)
#pragma unroll
                for (int m = 0; m < 4; ++m)
#pragma unroll
                    for (int bj = 0; bj < 2; ++bj)
#pragma unroll
                        for (int n = 0; n < 2; ++n) *(f32x4*)(st + (size_t)((((ai * 4 + m) * 2 + bj) * 2 + n) * 2048)) = acc[ai][bj][m][n];
        } else {
            const int b = u.pn >> 2, g = u.pn & 3;
            const float sgn = (fr & 1) ? -1.f : 1.f;
            f32x4 ny[2][2];
#pragma unroll
            for (int bj = 0; bj < 2; ++bj) { const u32x4 nv = *(const u32x4*)(nyq + (size_t)u.pn * 256 + bj * 128 + wc * 32 + fq * 8);
                ny[bj][0] = (f32x4){bflo(nv.x), bfhi(nv.x), bflo(nv.y), bfhi(nv.y)} * sgn; ny[bj][1] = (f32x4){bflo(nv.z), bfhi(nv.z), bflo(nv.w), bfhi(nv.w)} * sgn; }
#pragma unroll
            for (int ai = 0; ai < 2; ++ai)
#pragma unroll
                for (int m = 0; m < 4; ++m) {
                    const int kk = u.pm * 256 + ai * 128 + wr * 64 + m * 16 + fr;
                    bf16_t* r1 = Fo + ((size_t)b * 4096 + kk) * 1024 + g * 256 + wc * 32 + fq * 8;
                    bf16_t* r2 = Fo + ((size_t)b * 4096 + (4096 - kk)) * 1024 + g * 256 + wc * 32 + fq * 8;
#pragma unroll
                    for (int bj = 0; bj < 2; ++bj) {
                        const f32x4 c0 = *(const f32x4*)(st + (size_t)((((ai * 4 + m) * 2 + bj) * 2 + 0) * 2048)) + ny[bj][0], c1 = *(const f32x4*)(st + (size_t)((((ai * 4 + m) * 2 + bj) * 2 + 1) * 2048)) + ny[bj][1];
                        const f32x4 s0 = acc[ai][bj][m][0], s1 = acc[ai][bj][m][1];
                        const f32x4 p0 = c0 + s0, p1 = c1 + s1, q0 = c0 - s0, q1 = c1 - s1;
                        u32x4 w; w.x = cvt_pk_bf16(p0[0], p0[1]); w.y = cvt_pk_bf16(p0[2], p0[3]); w.z = cvt_pk_bf16(p1[0], p1[1]); w.w = cvt_pk_bf16(p1[2], p1[3]);
                        *(u32x4*)(r1 + bj * 128) = w;
                        u32x4 x; x.x = cvt_pk_bf16(q0[0], q0[1]); x.y = cvt_pk_bf16(q0[2], q0[3]); x.z = cvt_pk_bf16(q1[0], q1[1]); x.w = cvt_pk_bf16(q1[2], q1[3]);
                        if (kk != 0) *(u32x4*)(r2 + bj * 128) = x; }
                    if (m & 1) asm volatile("" ::: "memory");
                }
        }
#pragma unroll
        for (int ai = 0; ai < 2; ++ai)
#pragma unroll
            for (int bj = 0; bj < 2; ++bj)
#pragma unroll
                for (int m = 0; m < 4; ++m)
#pragma unroll
                    for (int n = 0; n < 2; ++n) acc[ai][bj][m][n] *= 0.f;
    }
};
struct EpiZ1 {
    typedef PreNone Pre;
    __device__ __forceinline__ void pre_load(const Unit& u, int wr, int fr, int fq, Pre& P) const {  }
    static constexpr bool PERM = true, KEEP = false;
    const float* ssq; bf16_t* zp;
    __device__ __forceinline__ void operator()(f32x4 (&acc)[2][2][4][2], const Unit& u, int wr, int wc, int fr, int fq, const Pre& pre) const {
        const int gg = u.pm >> 1, ri = u.pm & 1, b = u.pn >> 4, s0 = (u.pn & 15) * 256;
        float rs[2][8];
#pragma unroll
        for (int bj = 0; bj < 2; ++bj)
#pragma unroll
            for (int i = 0; i < 8; ++i) { const int tok = u.pn * 256 + bj * 128 + wc * 32 + fq * 8 + i;
                float s = ssq[(size_t)tok * 16 + fr]; s += __shfl_xor(s, 1); s += __shfl_xor(s, 2); s += __shfl_xor(s, 4); s += __shfl_xor(s, 8);
                rs[bj][i] = rsqrtf(s * (1.f / 1024.f) + 1e-6f); }
#pragma unroll
        for (int ai = 0; ai < 2; ++ai)
#pragma unroll
            for (int m = 0; m < 4; ++m) {
                const int l = ai * 128 + wr * 64 + m * 16 + fr;
                bf16_t* rowp = zp + ((size_t)((b * 4 + gg) * 256 + l)) * 8192 + ri * 4096 + s0;
#pragma unroll
                for (int bj = 0; bj < 2; ++bj) { const f32x4 v0 = acc[ai][bj][m][0], v1 = acc[ai][bj][m][1];
                    u32x4 w; w.x = cvt_pk_bf16(v0[0] * rs[bj][0], v0[1] * rs[bj][1]); w.y = cvt_pk_bf16(v0[2] * rs[bj][2], v0[3] * rs[bj][3]);
                    w.z = cvt_pk_bf16(v1[0] * rs[bj][4], v1[1] * rs[bj][5]); w.w = cvt_pk_bf16(v1[2] * rs[bj][6], v1[3] * rs[bj][7]);
                    *(u32x4*)(rowp + bj * 128 + wc * 32 + fq * 8) = w; }
            }
    }
};

__device__ __forceinline__ void conv_wt(const float* __restrict__ W, int K, int N, bf16_t* __restrict__ dst, const float* __restrict__ gain, int mode, int cs_lo, int cs_hi, float cs, size_t gtid, size_t gstride) {
    const size_t total = (size_t)(K / 8) * N;
#pragma unroll 4
    for (size_t idx = gtid; idx < total; idx += gstride) {
        const int n = (int)(idx % N), k0 = (int)(idx / N) * 8; float v[8];
        const float sc = (n >= cs_lo && n < cs_hi) ? cs : 1.f;
#pragma unroll
        for (int j = 0; j < 8; ++j) { v[j] = W[(size_t)(k0 + j) * N + n] * sc; if (gain) v[j] *= gain[k0 + j]; }
        const int drow = mode == 0 ? n : ((n >> 7) * 256 + (mode == 2 ? 128 : 0) + (n & 127));
        u32x4 w; w.x = cvt_pk_bf16(v[0], v[1]); w.y = cvt_pk_bf16(v[2], v[3]); w.z = cvt_pk_bf16(v[4], v[5]); w.w = cvt_pk_bf16(v[6], v[7]);
        *(u32x4*)(dst + (size_t)drow * K + k0) = w;
    }
}

__device__ __forceinline__ void phase_prep(const Params& p) {
    const size_t gtid = (size_t)blockIdx.x * blockDim.x + threadIdx.x, gstride = (size_t)gridDim.x * blockDim.x;
    bf16_t* wb = (bf16_t*)(p.ws + WS_W);
    for (int j = 0; j < 2; ++j) {
        conv_wt(p.ret_w_in + (size_t)j * 1024 * 6144, 1024, 6144, wb + W_IN + (size_t)j * 6291456, p.norm_mix + (size_t)(2 * j) * 1024, 0, 1024, 2048, 0.0625f, gtid, gstride);
        conv_wt(p.ret_w_out + (size_t)j * 2048 * 1024, 2048, 1024, wb + W_OUT + (size_t)j * 2097152, nullptr, 0, 0, 0, 1.f, gtid, gstride);
        conv_wt(p.fno_w + (size_t)j * 1048576, 1024, 1024, wb + W_FNO + (size_t)j * 1048576, nullptr, 0, 0, 0, 1.f, gtid, gstride);
        const float* gain = p.norm_mix + (size_t)(2 * j + 1) * 1024;
        for (size_t idx = gtid; idx < 524288; idx += gstride) { const int c = (int)(idx & 255), np = (int)((idx >> 8) & 511), g = (int)(idx >> 17);
            const float ph = (float)((c * (np & 255)) & 255) * (1.f / 256.f);
            const float v = (np < 256 ? __builtin_amdgcn_cosf(ph) : -__builtin_amdgcn_sinf(ph)) * gain[g * 256 + c] * (1.f / 1024.f);
            wb[W_DFT + (size_t)j * 524288 + idx] = f2bf(v); }
    }
    for (int i = 0; i < 4; ++i) {
        conv_wt(p.w_gate + (size_t)i * 1024 * DFF, 1024, DFF, wb + W_GU + (size_t)i * 5767168, p.norm_ffn + (size_t)i * 1024, 1, 0, 0, 1.f, gtid, gstride);
        conv_wt(p.w_up + (size_t)i * 1024 * DFF, 1024, DFF, wb + W_GU + (size_t)i * 5767168, p.norm_ffn + (size_t)i * 1024, 2, 0, 0, 1.f, gtid, gstride);
        conv_wt(p.w_down + (size_t)i * DFF * 1024, DFF, 1024, wb + W_DN + (size_t)i * 2883584, nullptr, 0, 0, 0, 1.f, gtid, gstride);
        conv_wt(p.ple_wg + (size_t)i * 1048576, 1024, 1024, wb + W_PG + (size_t)i * 1048576, p.norm_ple + (size_t)i * 1024, 0, 0, 0, 1.f, gtid, gstride);
        conv_wt(p.ple_wp + (size_t)i * 262144, 256, 1024, wb + W_PP + (size_t)i * 262144, nullptr, 0, 0, 0, 1.f, gtid, gstride);
    }
    unsigned* __restrict__ rope = (unsigned*)(p.ws + WS_ROPE); const int* __restrict__ posp = p.pos;
#pragma unroll 4
    for (size_t idx = gtid; idx < (size_t)T * 128; idx += gstride) {
        const int d = (int)(idx & 127); const int tok = (int)(idx >> 7);
        const float freq = 1.0f / exp2f(13.287712379549449f * ((float)d * (1.0f / 127.0f)));
        const float ang = (float)posp[tok] * freq;
        const double rev = (double)ang * 0.15915494309189535; const float fr = (float)(rev - __builtin_rint(rev));
        h16x2 cs; cs.x = (_Float16)__builtin_amdgcn_cosf(fr); cs.y = (_Float16)__builtin_amdgcn_sinf(fr);
        rope[idx] = __builtin_bit_cast(unsigned, cs);
    }
    const int lane = threadIdx.x & 63; const size_t gw = gtid >> 6, nw = gstride >> 6;
    bf16_t* xb = (bf16_t*)p.out; float* ssq = (float*)(p.ws + WS_SSQ);
#pragma unroll 2
    for (size_t row = gw; row < (size_t)T; row += nw) {
        float s = 0.f;
#pragma unroll
        for (int j = 0; j < 4; ++j) { const size_t off = row * 1024 + j * 256 + lane * 4; const f32x4 v = *(const f32x4*)(p.x + off); s += sum4(v * v);
            u32x2 w; w.x = cvt_pk_bf16(v[0], v[1]); w.y = cvt_pk_bf16(v[2], v[3]); *(u32x2*)(xb + off) = w; }
#pragma unroll
        for (int o = 1; o < 64; o <<= 1) s += __shfl_xor(s, o);
        if (lane < 16) ssq[row * 16 + lane] = lane == 0 ? s : 0.f;
    }
}

constexpr size_t WS_BAR = 243 * MiB;
#define XB_TMO      128
#define XB_XCNT(j)  (256  + 64 * (j))
#define XB_XSUB(j)  (1280 + 64 * (j))
#define XB_XGEN(j)  (2304 + 64 * (j))
#define XB_TOP      3328
#define XB_TOPGEN   3392
#define XCD_BAR_WORDS 3456
#define XB_SPIN_CAP (1u << 20)
__device__ __forceinline__ unsigned xb_ld(unsigned* p)              { return __hip_atomic_load(p, __ATOMIC_RELAXED, __HIP_MEMORY_SCOPE_AGENT); }
__device__ __forceinline__ unsigned xb_add(unsigned* p, unsigned v) { return __hip_atomic_fetch_add(p, v, __ATOMIC_RELAXED, __HIP_MEMORY_SCOPE_AGENT); }
__device__ __forceinline__ unsigned xb_xcc_id() { return (unsigned)__builtin_amdgcn_s_getreg((3 << 11) | 20) & 0xFu; }
#define XB_SPIN(cond, bar) do { unsigned _sp = 0; while (cond) { __builtin_amdgcn_s_sleep(1); \
    if ((++_sp & 255u) == 0u) { if (xb_ld(&(bar)[XB_TMO])) break; if (_sp > XB_SPIN_CAP) { atomicAdd(&(bar)[XB_TMO], 1u); break; } } } } while (0)
__device__ __forceinline__ void xcd_census(unsigned* bar, unsigned x, unsigned& nloc, unsigned& nx) {
    const unsigned G = gridDim.x; unsigned sum, cnt, mine, sp = 0u;
    for (;;) {
        sum = 0u; cnt = 0u; mine = 0u;
#pragma unroll
        for (unsigned j = 0; j < 16; ++j) { const unsigned c = xb_ld(&bar[XB_XCNT(j)]); sum += c; cnt += (c > 0u) ? 1u : 0u; mine = (j == x) ? c : mine; }
        if (sum == G) break;
        __builtin_amdgcn_s_sleep(1);
        if ((++sp & 255u) == 0u) { if (xb_ld(&bar[XB_TMO])) break; if (sp > XB_SPIN_CAP) { atomicAdd(&bar[XB_TMO], 1u); break; } }
    }
    nloc = mine > 0u ? mine : 1u; nx = cnt > 0u ? cnt : 1u;
}
__device__ __forceinline__ void grid_bar(unsigned* bar) {
    asm volatile("s_waitcnt vmcnt(0)" ::: "memory");
    __syncthreads();
    if (threadIdx.x == 0) {
        __builtin_amdgcn_s_waitcnt(0);
        const unsigned x = xb_xcc_id();
        unsigned* mine = bar + XCD_BAR_WORDS + 2 * blockIdx.x;
        unsigned nloc = mine[0], nx = mine[1];
        if (nloc == 0u) { xcd_census(bar, x, nloc, nx); mine[0] = nloc; mine[1] = nx; }
        const unsigned old = xb_add(&bar[XB_XSUB(x)], 1u);
        const unsigned gen = old / nloc;
        if (old + 1u == (gen + 1u) * nloc) {
            __builtin_amdgcn_fence(__ATOMIC_RELEASE, "agent");
            asm volatile("s_waitcnt vmcnt(0)" ::: "memory");
            const unsigned og = xb_add(&bar[XB_TOP], 1u);
            const unsigned tg = og / nx;
            if (og + 1u == (tg + 1u) * nx) xb_add(&bar[XB_TOPGEN], 1u);
            else XB_SPIN(xb_ld(&bar[XB_TOPGEN]) == tg, bar);
            __builtin_amdgcn_fence(__ATOMIC_ACQUIRE, "agent");
            xb_add(&bar[XB_XGEN(x)], 1u);
            asm volatile("s_waitcnt vmcnt(0)" ::: "memory");
        } else {
            XB_SPIN(xb_ld(&bar[XB_XGEN(x)]) == gen, bar);
            __builtin_amdgcn_fence(__ATOMIC_ACQUIRE, "agent");
            asm volatile("s_waitcnt vmcnt(0)" ::: "memory");
        }
    }
    __syncthreads();
}

__global__ void __launch_bounds__(512, 2) fwd_kernel(const Params p) {
    extern __shared__ __attribute__((aligned(16))) unsigned char shm[];
    LAS unsigned char* lds = (LAS unsigned char*)shm;
#define gtid ((size_t)blockIdx.x * 512 + (size_t)tidl)
#define gstride ((size_t)gridDim.x * 512)
#define scr (ws + WS_SCR)
#define xb (xsel ? (bf16_t*)outl : (bf16_t*)(ws + WS_XB))
#define xb_oth (xsel ? (bf16_t*)(ws + WS_XB) : (bf16_t*)outl)
#define wb ((bf16_t*)(ws + WS_W))
#define ssq0 ((float*)(ws + WS_SSQ))
#define ssq1 ((float*)(ws + WS_SSQ) + (size_t)T * 16)
#define gst ((float*)(ws + WS_GST))
#define q_b ((bf16_t*)(scr + R_Q))
#define k_b ((bf16_t*)(scr + R_K))
#define ktf_b ((bf16_t*)(scr + R_KTF))
#define ktb_b ((bf16_t*)(scr + R_KTB))
#define vtc_b ((bf16_t*)(scr + R_VTC))
#define P_b ((bf16_t*)(scr + R_P))
#define rf_b ((bf16_t*)(scr + R_RF))
#define rb_b ((bf16_t*)(scr + R_RB))
#define o_b ((bf16_t*)(scr + R_O))
#define zp_b ((bf16_t*)(scr + Z_ZP))
#define F_b ((bf16_t*)(scr + Z_F))
#define dseq_b ((bf16_t*)(scr + Z_D))
#define H_b ((bf16_t*)(scr + F_H))
#define pp_b ((bf16_t*)(scr + F_PP))
#define pb_b ((bf16_t*)(scr + F_PB))
    int ph = 0, nrm = 0, xsel = 1;
#if COOP
    cg::grid_group grid = cg::this_grid();
    if (threadIdx.x == 0) (void)xb_add(&((unsigned*)(p.ws + WS_BAR))[XB_XCNT(xb_xcc_id())], 1u);
#define PH_BEGIN if (ph >= p.ph_lo && ph < p.ph_hi) { size_t zofs = 0; asm volatile("" : "+s"(zofs)); unsigned char* ws = p.ws + zofs; int tidl = threadIdx.x; asm volatile("" : "+v"(tidl)); float* outl = p.out + zofs;
#define PH_END if (ph + 1 < p.ph_hi) { if (p.ph_hi < 0) grid.sync(); else grid_bar((unsigned*)(p.ws + WS_BAR)); } } ++ph;
#else
#define PH_BEGIN if (ph >= p.ph_lo && ph < p.ph_hi) { size_t zofs = 0; asm volatile("" : "+s"(zofs)); unsigned char* ws = p.ws + zofs; int tidl = threadIdx.x; asm volatile("" : "+v"(tidl)); float* outl = p.out + zofs;
#define PH_END } ++ph;
#endif
#define SSQ_CUR ((nrm & 1) ? ssq1 : ssq0)
#define SSQ_NXT ((nrm & 1) ? ssq0 : ssq1)

    PH_BEGIN if (PHSEL(0)) phase_prep(p); PH_END

    for (int layer = 0; layer < 4; ++layer) {
        const int jj = layer >> 1;
        if ((layer & 1) == 0) {
#define decay (p.ret_decay + (size_t)jj * 8)
            for (int hf = 0; hf < 2; ++hf) {
                const int tok0 = hf * TH;
                PH_BEGIN if (PHSEL(1)) {
                    TileSched S; S.init(xb + (size_t)tok0 * 1024, wb + W_IN + (size_t)jj * 6291456, 1024, 1024, 128, 16);
                    EpiR1 E{SSQ_CUR, (const unsigned*)(ws + WS_ROPE), decay, q_b, k_b, ktf_b, ktb_b, vtc_b, tok0, lds + STAGE_BYTES};
                    gemm_phase(lds, S, E, 1024, 1024, 16);
                } PH_END
                PH_BEGIN if (PHSEL(2)) {
                    const int c = blockIdx.x;
#if !defined(SUB) || SUB == 0
                    { const bool act = c < 128; const int item = act ? c : 0, yy = item >> 3, bh = (item & 7) + 8 * (yy >> 2), dir = (yy >> 1) & 1, half = yy & 1, h = bh & 3;
                      bf16_t* rt = (dir ? rb_b : rf_b) + (size_t)bh * 16 * 131072 + (size_t)half * 65536;
                      if (act) { bf16_t* z = rt + (size_t)(dir ? 15 : 0) * 131072; unsigned zz = 0u; asm volatile("" : "+v"(zz)); for (int i = tidl; i < 8192; i += 512) *(u32x4*)(z + (size_t)i * 8) = (u32x4){zz, zz, zz, zz}; }
                      ScanSched S{(const char*)(vtc_b + (size_t)bh * 16 * 131072 + (size_t)half * 65536), (const char*)((dir ? ktb_b : ktf_b) + (size_t)bh * 16 * 65536), dir, act};
                      EpiScan E{rt, dir, decay + dir * 4 + h};
                      gemm_phase(lds, S, E, 256, 256, 4); }
#endif
#if !defined(SUB) || SUB == 1
                    { ScoreSched S{(const char*)q_b, (const char*)k_b, c >= 128 ? c - 128 : -1, (int)gridDim.x - 128};
                      EpiScore E{decay, P_b};
                      gemm_phase(lds, S, E, 256, 256, 4); }
#endif
                } PH_END
                PH_BEGIN if (PHSEL(3)) {
                    OutSched S{(const char*)scr, (int)gridDim.x, (int)blockIdx.x};
                    EpiOut E{decay, o_b, gst};
                    gemm_phase(lds, S, E, 256, 256, 4);
                } PH_END
                PH_BEGIN if (PHSEL(4)) {
                    TileSched S; S.init(xb + (size_t)tok0 * 1024, wb + W_IN + (size_t)jj * 6291456 + (size_t)4096 * 1024, 1024, 1024, 128, 8);
                    EpiGate E{SSQ_CUR, gst, p.ret_gn + (size_t)jj * 2048, o_b, tok0};
                    gemm_phase(lds, S, E, 1024, 1024, 16);
                } PH_END
                PH_BEGIN if (PHSEL(5)) {
                    TileSched S; S.init(o_b, wb + W_OUT + (size_t)jj * 2097152, 2048, 2048, 128, 4);
                    EpiResid<false> E{xb, xb, SSQ_NXT, nullptr, nullptr, tok0, nullptr};
                    gemm_phase(lds, S, E, 2048, 2048, 32);
                } PH_END
            }
            ++nrm;
        } else {
            PH_BEGIN if (PHSEL(6)) {
                for (size_t idx = gtid; idx < (size_t)2048 * 512; idx += gstride) { const int kk = (int)(idx >> 9), c8 = (int)(idx & 511) * 8; const int s0 = c8 & 2047; float v[8];
#pragma unroll
                    for (int i = 0; i < 8; ++i) { const float phs = (float)((kk * (s0 + i)) & 4095) * (1.f / 4096.f); v[i] = c8 < 2048 ? __builtin_amdgcn_cosf(phs) : __builtin_amdgcn_sinf(phs); }
                    u32x4 w; w.x = cvt_pk_bf16(v[0], v[1]); w.y = cvt_pk_bf16(v[2], v[3]); w.z = cvt_pk_bf16(v[4], v[5]); w.w = cvt_pk_bf16(v[6], v[7]);
                    *(u32x4*)(dseq_b + (size_t)kk * 4096 + c8) = w; }
                Z1Sched S{(const char*)(wb + W_DFT + (size_t)jj * 524288), (const char*)xb, (int)gridDim.x, (int)blockIdx.x};
                EpiZ1 E{SSQ_CUR, zp_b};
                gemm_phase(lds, S, E, 256, 1024, 4);
            } PH_END
            PH_BEGIN if (PHSEL(13)) {
                bf16_t* zf = (bf16_t*)(scr + Z_ZF); bf16_t* nyq = (bf16_t*)(scr + Z_NY);
                const int lane = tidl & 63; const size_t gw = gtid >> 6, nw = gstride >> 6;
                for (size_t col = gw; col < 16384; col += nw) { float alt = 0.f;
#pragma unroll 2
                for (int t4 = 0; t4 < 4; ++t4) { const int a = (t4 * 64 + lane) * 8;
                    const bf16_t* zr = zp_b + col * 8192; const bf16_t* zi = zr + 4096;
                    const u32x4 r0 = *(const u32x4*)(zr + a), r1 = *(const u32x4*)(zr + 4088 - a), r2 = *(const u32x4*)(zr + (a ? 4096 - a : 0));
                    const u32x4 i0 = *(const u32x4*)(zi + a), i1 = *(const u32x4*)(zi + 4088 - a), i2 = *(const u32x4*)(zi + (a ? 4096 - a : 0));
                    float dr[8], di[8], mr[8], mi[8];
#pragma unroll
                    for (int j = 0; j < 4; ++j) { dr[2 * j] = bflo(r0[j]); dr[2 * j + 1] = bfhi(r0[j]); di[2 * j] = bflo(i0[j]); di[2 * j + 1] = bfhi(i0[j]); }
#pragma unroll
                    for (int e = 1; e < 8; ++e) { mr[8 - e] = (e & 1) ? bfhi(r1[e >> 1]) : bflo(r1[e >> 1]); mi[8 - e] = (e & 1) ? bfhi(i1[e >> 1]) : bflo(i1[e >> 1]); }
                    mr[0] = a ? bflo(r2[0]) : 0.f; mi[0] = a ? bflo(i2[0]) : 0.f;
                    float er[8], oi[8];
#pragma unroll
                    for (int i = 0; i < 8; ++i) { er[i] = dr[i] + mr[i]; oi[i] = di[i] - mi[i]; }
                    if (a == 0) oi[0] = 0.f;
                    alt += ((er[0] - er[1]) + (er[2] - er[3])) + ((er[4] - er[5]) + (er[6] - er[7]));
                    u32x4 w; w.x = cvt_pk_bf16(er[0], er[1]); w.y = cvt_pk_bf16(er[2], er[3]); w.z = cvt_pk_bf16(er[4], er[5]); w.w = cvt_pk_bf16(er[6], er[7]);
                    *(u32x4*)(zf + col * 4096 + a) = w;
                    u32x4 x; x.x = cvt_pk_bf16(oi[0], oi[1]); x.y = cvt_pk_bf16(oi[2], oi[3]); x.z = cvt_pk_bf16(oi[4], oi[5]); x.w = cvt_pk_bf16(oi[6], oi[7]);
                    *(u32x4*)(zf + col * 4096 + 2048 + a) = x; }
#pragma unroll
                    for (int o2 = 1; o2 < 64; o2 <<= 1) alt += __shfl_xor(alt, o2);
                    if (lane == 0) { const bf16_t zn = zp_b[col * 8192 + 2048]; nyq[col] = zn; F_b[((size_t)(col >> 10) * 4096 + 2048) * 1024 + (col & 1023)] = f2bf(alt + bflo(zn)); } }
            } PH_END
            PH_BEGIN if (PHSEL(7)) {
                Z2Sched S{(const char*)dseq_b, (const char*)(scr + Z_ZF), (int)gridDim.x, (int)blockIdx.x};
                EpiZ2 E{F_b, (float*)(scr + Z_ST) + (size_t)blockIdx.x * 131072, (const bf16_t*)(scr + Z_NY)};
                gemm_phase(lds, S, E, 4096, 4096, 32);
            } PH_END
            PH_BEGIN if (PHSEL(8)) {
                TileSched S; S.init(F_b, wb + W_FNO + (size_t)jj * 1048576, 1024, 1024, 256, 4);
                EpiResid<false> E{xb, xb, SSQ_NXT, nullptr, nullptr, 0, nullptr};
                gemm_phase(lds, S, E, 1024, 1024, 16);
            } PH_END
            ++nrm;
        }
        PH_BEGIN if (PHSEL(9)) {
            TileSched S; S.init(xb, wb + W_GU + (size_t)layer * 5767168, 1024, 1024, 256, 22);
            EpiF1 E{SSQ_CUR, H_b};
            gemm_phase(lds, S, E, 1024, 1024, 16);
            const float* pl = p.p + (size_t)layer * T * 256;
#pragma unroll 4
            for (size_t idx = gtid; idx < (size_t)T * 32; idx += gstride) { const f32x4 a = *(const f32x4*)(pl + idx * 8), b = *(const f32x4*)(pl + idx * 8 + 4);
                u32x4 w; w.x = cvt_pk_bf16(a[0], a[1]); w.y = cvt_pk_bf16(a[2], a[3]); w.z = cvt_pk_bf16(b[0], b[1]); w.w = cvt_pk_bf16(b[2], b[3]); *(u32x4*)(pb_b + idx * 8) = w; }
        } PH_END
        PH_BEGIN if (PHSEL(10)) {
            { TileSched S; S.init(H_b, wb + W_DN + (size_t)layer * 2883584, DFF, DFF, 256, 4);
              EpiResid<false> E{xb, xb, SSQ_NXT, nullptr, nullptr, 0, nullptr};
              gemm_phase(lds, S, E, DFF, DFF, 44); }
            { TileSched S; S.init(pb_b, wb + W_PP + (size_t)layer * 262144, 256, 256, 256, 4);
              EpiPlain<false> E{pp_b, 1024};
              gemm_phase(lds, S, E, 256, 256, 4); }
        } PH_END
        ++nrm;
        PH_BEGIN if (PHSEL(11)) {
            TileSched S; S.init(xb, wb + W_PG + (size_t)layer * 1048576, 1024, 1024, 256, 4);
            EpiResid<true> E{xb, xb_oth, SSQ_NXT, SSQ_CUR, pp_b, 0, layer == 3 ? outl : nullptr};
            gemm_phase(lds, S, E, 1024, 1024, 16);
        } PH_END
        ++nrm; xsel ^= 1;
    }
    PH_BEGIN if (PHSEL(12)) {
        const int lane = tidl & 63; const size_t gw = gtid >> 6, nw = gstride >> 6; const float* ssq = SSQ_CUR;
        for (size_t row = gw; row < (size_t)T; row += nw) {
            float s = lane < 16 ? ssq[row * 16 + lane] : 0.f;
#pragma unroll
            for (int o = 1; o < 16; o <<= 1) s += __shfl_xor(s, o);
            s = __shfl(s, 0);
            const float rs = rsqrtf(s * (1.f / 1024.f) + 1e-6f);
#pragma unroll
            for (int j = 0; j < 4; ++j) { const size_t off = row * 1024 + j * 256 + lane * 4; const f32x4 g = *(const f32x4*)(p.final_norm + j * 256 + lane * 4);
                f32x4 v = *(const f32x4*)(outl + off); v = v * rs * g; *(f32x4*)(outl + off) = v; }
        }
    } PH_END
}

constexpr int LDS_TOTAL = STAGE_BYTES + 32768;
constexpr int N_PHASES = 1 + 2 * (10 + 3) + 2 * (4 + 3) + 1;

extern "C" void kernel_launch(void* const* d_in, const int* in_sizes, int n_in, void* d_out, int out_size, void* d_ws, size_t ws_size, hipStream_t stream) {
    static int ready = 0;
    if (!ready) {
        if (hipFuncSetAttribute((const void*)fwd_kernel, hipFuncAttributeMaxDynamicSharedMemorySize, LDS_TOTAL) != hipSuccess) { fprintf(stderr, "hipFuncSetAttribute failed\n"); ready = -1; return; }
        if (ws_size < 1000 * MiB) { fprintf(stderr, "workspace too small: %zu\n", ws_size); ready = -1; return; }
        ready = 1;
    }
    if (ready < 0) return;
    Params p{};
    p.x = (const float*)d_in[0]; p.p = (const float*)d_in[1]; p.pos = (const int*)d_in[2]; p.norm_mix = (const float*)d_in[3]; p.ret_w_in = (const float*)d_in[4]; p.ret_w_out = (const float*)d_in[5];
    p.ret_gn = (const float*)d_in[6]; p.ret_decay = (const float*)d_in[7]; p.fno_w = (const float*)d_in[8]; p.norm_ffn = (const float*)d_in[9]; p.w_gate = (const float*)d_in[10]; p.w_up = (const float*)d_in[11];
    p.w_down = (const float*)d_in[12]; p.norm_ple = (const float*)d_in[13]; p.ple_wg = (const float*)d_in[14]; p.ple_wp = (const float*)d_in[15]; p.final_norm = (const float*)d_in[16];
    p.out = (float*)d_out; p.ws = (unsigned char*)d_ws;
#if COOP
    p.ph_lo = 0; p.ph_hi = N_PHASES;
    hipMemsetAsync((unsigned char*)d_ws + WS_BAR, 0, (XCD_BAR_WORDS + 2 * 256) * 4, stream);
    void* args[] = {&p};
    hipError_t e = hipLaunchCooperativeKernel((const void*)fwd_kernel, dim3(256), dim3(512), args, LDS_TOTAL, stream);
    if (e != hipSuccess) fprintf(stderr, "cooperative launch failed: %s\n", hipGetErrorString(e));
#else
    for (int ph = 0; ph < N_PHASES; ++ph) { p.ph_lo = ph; p.ph_hi = ph + 1; hipLaunchKernelGGL(fwd_kernel, dim3(256), dim3(512), LDS_TOTAL, stream, p); }
#endif
}
```

```cpp
#include <hip/hip_runtime.h>
#include <hip/hip_cooperative_groups.h>
#include <cstdio>
namespace cg = cooperative_groups;

#define LAS __attribute__((address_space(3)))
typedef unsigned short bf16_t;
typedef short bf16x8 __attribute__((ext_vector_type(8)));
typedef float f32x4 __attribute__((ext_vector_type(4)));
typedef float f32x2 __attribute__((ext_vector_type(2)));
typedef unsigned u32x4 __attribute__((ext_vector_type(4)));
typedef unsigned u32x2 __attribute__((ext_vector_type(2)));
typedef _Float16 h16x2 __attribute__((ext_vector_type(2)));

#ifndef COOP
#define COOP 1
#endif
#ifndef ONLY
#define ONLY -1
#endif
#define EX2(x) __builtin_amdgcn_exp2f(x)
#ifndef EXPDUP
#define EXPDUP -1
#endif
#define PHSEL(k) (ONLY < 0 || ONLY == (k))) for (int rep_ = 0; rep_ < ((EXPDUP) == (k) ? 2 : 1); ++rep_) if ((true)

constexpr int T = 65536, D = 1024, SEQ = 4096, DFF = 2816;
constexpr int TH = 32768;
constexpr size_t MiB = (size_t)1 << 20;
constexpr size_t WS_XB = 0;
constexpr size_t WS_W = 128 * MiB;
constexpr size_t WS_ROPE = 244 * MiB;
constexpr size_t WS_SSQ = 276 * MiB;
constexpr size_t WS_GST = 284 * MiB;
constexpr size_t WS_SCR = 292 * MiB;
constexpr size_t R_Q = 0, R_K = 64 * MiB, R_KTF = 128 * MiB, R_KTB = 192 * MiB, R_VTC = 256 * MiB, R_P = 384 * MiB, R_RF = 448 * MiB, R_RB = 576 * MiB;
constexpr size_t R_O = 64 * MiB;
constexpr size_t F_H = 0, F_PP = 352 * MiB, F_PB = 480 * MiB;
constexpr size_t Z_ZP = 0, Z_F = 256 * MiB, Z_D = 384 * MiB, Z_NY = 416 * MiB, Z_ST = 448 * MiB, Z_ZF = 576 * MiB;
constexpr size_t W_IN = 0;
constexpr size_t W_OUT = W_IN + 2 * 6291456;
constexpr size_t W_FNO = W_OUT + 2 * 2097152;
constexpr size_t W_DFT = W_FNO + 2 * 1048576;
constexpr size_t W_GU = W_DFT + 2 * 524288;
constexpr size_t W_DN = W_GU + 4 * 5767168;
constexpr size_t W_PG = W_DN + 4 * 2883584;
constexpr size_t W_PP = W_PG + 4 * 1048576;

struct Params {
    const float* x; const float* p; const int* pos; const float* norm_mix; const float* ret_w_in; const float* ret_w_out; const float* ret_gn; const float* ret_decay;
    const float* fno_w; const float* norm_ffn; const float* w_gate; const float* w_up; const float* w_down; const float* norm_ple; const float* ple_wg; const float* ple_wp; const float* final_norm;
    float* out; unsigned char* ws; int ph_lo, ph_hi;
};

__device__ __forceinline__ unsigned cvt_pk_bf16(float lo, float hi) { unsigned r; asm("v_cvt_pk_bf16_f32 %0, %1, %2" : "=v"(r) : "v"(lo), "v"(hi)); return r; }
__device__ __forceinline__ bf16_t f2bf(float f) { return (bf16_t)(cvt_pk_bf16(f, 0.f) & 0xffffu); }
__device__ __forceinline__ float bflo(unsigned w) { return __uint_as_float(w << 16); }
__device__ __forceinline__ float bfhi(unsigned w) { return __uint_as_float(w & 0xffff0000u); }
__device__ __forceinline__ float silu_f(float v) { return v * __builtin_amdgcn_rcpf(1.f + __expf(-v)); }
__device__ __forceinline__ float sigmoid_f(float v) { return __builtin_amdgcn_rcpf(1.f + __expf(-v)); }
__device__ __forceinline__ float lg2sig(float logit) { return -__log2f(1.f + __expf(-logit)); }
__device__ __forceinline__ float sum4(f32x4 v) { return (v[0] + v[1]) + (v[2] + v[3]); }
__device__ __forceinline__ float row_rstd(const float* ssq, int tok, int fq) {
    float s = sum4(*(const f32x4*)(ssq + (size_t)tok * 16 + fq * 4));
    s += __shfl_xor(s, 16); s += __shfl_xor(s, 32);
    return rsqrtf(s * (1.f / 1024.f) + 1e-6f);
}

struct PreNone { };
struct PreRs { float rs[8]; };
__device__ __forceinline__ void pre_rs(PreRs& P, const float* ssq, int row0, int wr, int fr, int fq) {
#pragma unroll
    for (int i = 0; i < 8; ++i) P.rs[i] = row_rstd(ssq, row0 + (i >> 2) * 128 + wr * 64 + (i & 3) * 16 + fr, fq);
#pragma unroll
    for (int i = 0; i < 8; ++i) asm volatile("" : "+v"(P.rs[i]));
}

constexpr int BM = 256, BK = 64, HALF = 128, HTB = HALF * BK * 2, STAGE_BYTES = 8 * HTB, NXCD = 8, WGM = 8;
__device__ __forceinline__ int lds_byte(int r, int c) { const int st = (r >> 4) * 2 + (c >> 5), rr = r & 15, cc = c & 31, ob = rr * 64 + cc * 2; return st * 1024 + (ob ^ (((ob >> 9) & 1) << 5)); }
__device__ __forceinline__ void stage_rc(int b, int& R, int& C) { const int st = b / 1024, sb = b % 1024, swz = sb ^ (((sb >> 9) & 1) << 5); R = (st >> 1) * 16 + swz / 64; C = (st & 1) * 32 + (swz % 64) / 2; }
__device__ __forceinline__ int perm32(int rho) { const int n = rho >> 4, i = rho & 15; return 8 * (i >> 2) + 4 * n + (i & 3); }
struct Unit { int pm, pn, z; };
__device__ __forceinline__ const char* uni(const char* p) { const unsigned long long v = (unsigned long long)p; const unsigned lo = __builtin_amdgcn_readfirstlane((unsigned)v), hi = __builtin_amdgcn_readfirstlane((unsigned)(v >> 32)); return (const char*)(((unsigned long long)hi << 32) | lo); }

template <class Epi, class Sched>
__device__ __forceinline__ void gemm_phase(LAS unsigned char* lds, const Sched& S, const Epi& E, const int lda, const int ldb, const int nt) {
    int tid = threadIdx.x; asm volatile("" : "+v"(tid));
    const int wid = __builtin_amdgcn_readfirstlane(tid >> 6), lane = tid & 63, wr = wid >> 2, wc = wid & 3, fr = lane & 15, fq = lane >> 4;
    unsigned voffA[2], voffB[2];
#pragma unroll
    for (int i = 0; i < 2; ++i) { int R, C; stage_rc(tid * 16 + i * 8192, R, C); const int Rb = Epi::PERM ? ((R & ~31) + perm32(R & 31)) : R;
        voffA[i] = (unsigned)(R * lda + C) * 2u; voffB[i] = (unsigned)(Rb * ldb + C) * 2u; }
    const size_t kstep = (size_t)(BK * 2);
    const size_t hstepA = (size_t)HALF * lda * 2, hstepB = (size_t)HALF * ldb * 2;
    const unsigned ldsbase = __builtin_amdgcn_readfirstlane((unsigned)(__UINTPTR_TYPE__)lds + (unsigned)wid * 1024u);
    const int aoff = lds_byte(wr * 64 + fr, fq * 8), boff = lds_byte(wc * 32 + fr, fq * 8);
#define G_SA(b, h) (((b) * 2 + (h)) * HTB)
#define G_SB(b, h) ((4 + (b) * 2 + (h)) * HTB)
#define G_STAGE(bufoff, gbase, voff) do { _Pragma("unroll") for (int _i = 0; _i < 2; ++_i) \
        asm volatile("s_mov_b32 m0, %0\n\ts_nop 0\n\tglobal_load_lds_dwordx4 %1, %2" :: "s"(ldsbase + (unsigned)((bufoff) + _i * 8192)), "v"((voff)[_i]), "s"((const char*)(gbase)) : "m0", "memory"); } while (0)
#define G_LDA(dst, b, h) do { _Pragma("unroll") for (int m = 0; m < 4; ++m) _Pragma("unroll") for (int k = 0; k < 2; ++k) dst[m][k] = *(const LAS bf16x8*)(lds + G_SA(b, h) + aoff + m * 2048 + k * 1024); } while (0)
#define G_LDB(dst, b, h) do { _Pragma("unroll") for (int n = 0; n < 2; ++n) _Pragma("unroll") for (int k = 0; k < 2; ++k) dst[n][k] = *(const LAS bf16x8*)(lds + G_SB(b, h) + boff + n * 2048 + k * 1024); } while (0)
#define G_MMA(ai, bj, At, Bt) do { __builtin_amdgcn_s_setprio(1); _Pragma("unroll") for (int m = 0; m < 4; ++m) _Pragma("unroll") for (int n = 0; n < 2; ++n) _Pragma("unroll") for (int k = 0; k < 2; ++k) \
        acc[ai][bj][m][n] = __builtin_amdgcn_mfma_f32_16x16x32_bf16(Bt[n][k], At[m][k], acc[ai][bj][m][n], 0, 0, 0); __builtin_amdgcn_s_setprio(0); } while (0)
#define G_WAIT_V(n) asm volatile("s_waitcnt vmcnt(" #n ")" ::: "memory")
#define G_WAIT_L(n) asm volatile("s_waitcnt lgkmcnt(" #n ")" ::: "memory")
#define G_BAR __builtin_amdgcn_s_barrier()
#define G_SCHED __builtin_amdgcn_sched_barrier(0)
    Unit cur, nxt; int ui = 0;
    if (!S.next(0, cur)) return;
    f32x4 acc[2][2][4][2];
#pragma unroll
    for (int a = 0; a < 2; ++a)
#pragma unroll
        for (int b = 0; b < 2; ++b)
#pragma unroll
            for (int m = 0; m < 4; ++m)
#pragma unroll
                for (int n = 0; n < 2; ++n) acc[a][b][m][n] = (f32x4){0.f, 0.f, 0.f, 0.f};
    bf16x8 At[4][2], B0[2][2], B1[2][2];
    const char* cA; const char* cB; S.ptrs(cur, cA, cB); cA = uni(cA); cB = uni(cB);
    typename Epi::Pre pre; E.pre_load(cur, wr, fr, fq, pre);
    G_STAGE(G_SB(0, 0), cB, voffB); G_STAGE(G_SA(0, 0), cA, voffA); G_STAGE(G_SB(0, 1), uni(cB + hstepB), voffB); G_STAGE(G_SA(0, 1), uni(cA + hstepA), voffA);
    if (wr == 1) G_BAR;
    G_WAIT_V(4); G_BAR;
    G_STAGE(G_SB(1, 0), uni(cB + kstep), voffB); G_STAGE(G_SA(1, 0), uni(cA + kstep), voffA); G_STAGE(G_SB(1, 1), uni(cB + hstepB + kstep), voffB);
    G_WAIT_V(6); G_BAR;
    for (;;) {
        const bool has_next = S.next(ui + 1, nxt);
        const char* nA = cA; const char* nB = cB; if (has_next) { S.ptrs(nxt, nA, nB); nA = uni(nA); nB = uni(nB); }
        for (int t = 0; t < nt; t += 2) {
            const bool last = (t == nt - 2);
            const char* a1 = uni(cA + (size_t)(t + 1) * kstep);
            const char* a2 = uni(last ? nA : cA + (size_t)(t + 2) * kstep); const char* b2 = uni(last ? nB : cB + (size_t)(t + 2) * kstep);
            const char* a3 = uni(a2 + kstep); const char* b3 = uni(b2 + kstep);
            const char* a1h = uni(a1 + hstepA); const char* a2h = uni(a2 + hstepA); const char* b2h = uni(b2 + hstepB); const char* b3h = uni(b3 + hstepB);
            G_LDB(B0, 0, 0); G_SCHED; G_LDA(At, 0, 0); G_STAGE(G_SA(1, 1), a1h, voffA);
            G_WAIT_L(8); G_BAR; G_WAIT_L(0); G_MMA(0, 0, At, B0); G_BAR; G_SCHED;
            G_LDB(B1, 0, 1); G_STAGE(G_SB(0, 0), b2, voffB);
            G_BAR; G_WAIT_L(0); G_MMA(0, 1, At, B1); G_BAR;
            G_LDA(At, 0, 1); G_STAGE(G_SA(0, 0), a2, voffA);
            G_BAR; G_WAIT_L(0); G_MMA(1, 0, At, B0); G_BAR; G_SCHED;
            G_STAGE(G_SB(0, 1), b2h, voffB);
            G_WAIT_V(6); G_BAR; G_MMA(1, 1, At, B1); G_BAR;
            G_LDB(B0, 1, 0); G_SCHED; G_LDA(At, 1, 0); G_STAGE(G_SA(0, 1), a2h, voffA);
            G_WAIT_L(8); G_BAR; G_WAIT_L(0); G_MMA(0, 0, At, B0); G_BAR; G_SCHED;
            G_LDB(B1, 1, 1); G_STAGE(G_SB(1, 0), b3, voffB);
            G_BAR; G_WAIT_L(0); G_MMA(0, 1, At, B1); G_BAR;
            G_LDA(At, 1, 1); G_STAGE(G_SA(1, 0), a3, voffA);
            G_BAR; G_WAIT_L(0); G_MMA(1, 0, At, B0); G_BAR; G_SCHED;
            G_STAGE(G_SB(1, 1), b3h, voffB);
            G_WAIT_V(6); G_BAR; G_MMA(1, 1, At, B1); G_BAR;
        }
        { int fr_o = fr, fq_o = fq; asm volatile("" : "+v"(fr_o), "+v"(fq_o)); E(acc, cur, wr, wc, fr_o, fq_o, pre); }
        if (!has_next) break;
        if (!Epi::KEEP) {
#pragma unroll
            for (int a = 0; a < 2; ++a)
#pragma unroll
                for (int b = 0; b < 2; ++b)
#pragma unroll
                    for (int m = 0; m < 4; ++m)
#pragma unroll
                        for (int n = 0; n < 2; ++n) acc[a][b][m][n] = (f32x4){0.f, 0.f, 0.f, 0.f};
        }
        cur = nxt; cA = nA; cB = nB; ++ui;
        E.pre_load(cur, wr, fr, fq, pre);
    }
    G_WAIT_V(0);
    if (wr == 0) G_BAR;
    G_BAR;
#undef G_SA
#undef G_SB
#undef G_STAGE
#undef G_LDA
#undef G_LDB
#undef G_MMA
#undef G_WAIT_V
#undef G_WAIT_L
#undef G_BAR
#undef G_SCHED
}

struct TileSched {
    const char* A; const char* B; size_t sA, sB; int nM, nN, nwg, G, c;
    __device__ __forceinline__ void init(const void* A_, const void* B_, int lda, int ldb, int nM_, int nN_) {
        A = (const char*)A_; B = (const char*)B_; sA = (size_t)BM * lda * 2; sB = (size_t)BM * ldb * 2; nM = nM_; nN = nN_; nwg = nM * nN; G = gridDim.x; c = blockIdx.x; }
    __device__ __forceinline__ bool next(int i, Unit& u) const {
        const long L = (long)i * G + c; if (L >= nwg) return false;
        int wgid = (int)L; { const int q = nwg / NXCD, r = nwg % NXCD, xcd = wgid % NXCD, off = wgid / NXCD; wgid = (xcd < r ? xcd * (q + 1) : r * (q + 1) + (xcd - r) * q) + off; }
        const int nig = WGM * nN, gid = wgid / nig, fm = gid * WGM, gsz = (nM - fm) < WGM ? (nM - fm) : WGM;
        u.pm = fm + ((wgid % nig) % gsz); u.pn = (wgid % nig) / gsz; u.z = 0; return true;
    }
    __device__ __forceinline__ void ptrs(const Unit& u, const char*& a, const char*& b) const { a = A + (size_t)u.pm * sA; b = B + (size_t)u.pn * sB; }
};
struct Z1Sched {
    const char* W; const char* X; int G, c;
    __device__ __forceinline__ bool next(int i, Unit& u) const { if (i * G + c >= 2048) return false; const int x = c & 7, y = c >> 3; u.pm = ((x & 3) << 1) | (y & 1); u.pn = i * (G >> 3) + (x >> 2) + 2 * (y >> 1); u.z = 0; return true; }
    __device__ __forceinline__ void ptrs(const Unit& u, const char*& a, const char*& b) const { a = W + (size_t)u.pm * (256 * 256 * 2); b = X + (size_t)u.pn * (256 * 1024 * 2) + (size_t)(u.pm >> 1) * 512; }
};
struct ScanSched {
    const char* vtc; const char* kt; int dir; bool active;
    __device__ __forceinline__ bool next(int i, Unit& u) const { if (!active || i >= 16) return false; u.z = i; u.pm = dir ? 15 - i : i; u.pn = 0; return true; }
    __device__ __forceinline__ void ptrs(const Unit& u, const char*& a, const char*& b) const { a = vtc + (size_t)u.pm * (131072 * 2); b = kt + (size_t)u.pm * (65536 * 2); }
};
struct ScoreSched {
    const char* q; const char* k; int c, stride;
    __device__ __forceinline__ bool next(int i, Unit& u) const { if (c < 0) return false; const int L = i * stride + c; if (L >= 512) return false; u.pm = L; u.pn = 0; u.z = 0; return true; }
    __device__ __forceinline__ void ptrs(const Unit& u, const char*& a, const char*& b) const { a = q + (size_t)u.pm * (65536 * 2); b = k + (size_t)u.pm * (65536 * 2); }
};
struct OutSched {
    const char* scr; int G, c;
    __device__ __forceinline__ bool next(int i, Unit& u) const { const int k = i / 3; if (k * G + c >= 1024) return false; u.pn = (c >> 3) & 1; u.pm = k * (G >> 1) + (c & 7) + 8 * (c >> 4); u.z = i - k * 3; return true; }
    __device__ __forceinline__ void ptrs(const Unit& u, const char*& a, const char*& b) const {
        const size_t ro = ((size_t)u.pm * 512 + (size_t)u.pn * 256) * 256 * 2;
        const size_t z1 = (size_t)(u.z == 1), z2 = (size_t)(u.z == 2);
        a = scr + R_Q + z2 * (R_P - R_Q) + (size_t)u.pm * (65536 * 2);
        b = scr + R_RB - z1 * (R_RB - R_RF) - z2 * (R_RB - R_VTC) + ro; }
};

__device__ __forceinline__ void tr_write8(LAS unsigned char* tw, int r, int fq, const u32x4 w) {
#pragma unroll
    for (int i = 0; i < 8; ++i) { const unsigned v = w[i >> 1];
        *(LAS unsigned short*)(tw + (fq * 8 + i) * 128 + ((((r >> 3) ^ ((i ^ fq) & 7))) << 4) + (r & 7) * 2) = (unsigned short)((i & 1) ? (v >> 16) : (v & 0xffffu)); }
}
struct EpiR1 {
    typedef PreRs Pre;
    __device__ __forceinline__ void pre_load(const Unit& u, int wr, int fr, int fq, Pre& P) const { pre_rs(P, ssq, tok0 + u.pm * 256, wr, fr, fq); }
    static constexpr bool PERM = true, KEEP = false;
    const float* ssq; const unsigned* rope; const float* decay; bf16_t* q; bf16_t* k; bf16_t* ktf; bf16_t* ktb; bf16_t* vtc; int tok0; LAS unsigned char* tl;
    __device__ __forceinline__ void operator()(f32x4 (&acc)[2][2][4][2], const Unit& u, int wr, int wc, int fr, int fq, const Pre& pre) const {
        const int bl = u.pm >> 4, chunk = u.pm & 15, cbase = wc * 32 + fq * 8;
        LAS unsigned char* tw = tl + (wr * 4 + wc) * 4096;
        const int lane = fq * 16 + fr, tc = lane >> 3, jg = lane & 7;
        const float (&rsv)[8] = pre.rs;
        if (u.pn < 8) {
            const bool isk = u.pn >= 4; const int h = u.pn & 3;
            const float lgf = lg2sig(decay[h]), lgb = lg2sig(decay[4 + h]);
            bf16_t* dst = (isk ? k : q) + ((size_t)(bl * 4 + h) * 4096 + chunk * 256) * 256;
            const size_t tb = ((size_t)(bl * 4 + h) * 16 + chunk) * 65536;
#pragma unroll
            for (int ai = 0; ai < 2; ++ai) {
                u32x4 w2s[4];
#pragma unroll
                for (int m = 0; m < 4; ++m) {
                    if (m == 0) asm volatile("" ::: "memory");
                    const int j = ai * 128 + wr * 64 + m * 16 + fr; const int tok = tok0 + u.pm * 256 + j;
                    const float rs = rsv[ai * 4 + m];
                    const u32x4 r0 = *(const u32x4*)(rope + (size_t)tok * 128 + cbase), r1 = *(const u32x4*)(rope + (size_t)tok * 128 + cbase + 4);
                    float o1[8], o2[8];
#pragma unroll
                    for (int n = 0; n < 2; ++n)
#pragma unroll
                        for (int jj = 0; jj < 4; ++jj) {
                            const h16x2 cs = __builtin_bit_cast(h16x2, n == 0 ? r0[jj] : r1[jj]); const float c = (float)cs.x, s = (float)cs.y;
                            const float x1 = acc[ai][0][m][n][jj] * rs, x2 = acc[ai][1][m][n][jj] * rs;
                            o1[n * 4 + jj] = x1 * c - x2 * s; o2[n * 4 + jj] = x1 * s + x2 * c; }
                    u32x4 w1, w2;
                    w1.x = cvt_pk_bf16(o1[0], o1[1]); w1.y = cvt_pk_bf16(o1[2], o1[3]); w1.z = cvt_pk_bf16(o1[4], o1[5]); w1.w = cvt_pk_bf16(o1[6], o1[7]);
                    w2.x = cvt_pk_bf16(o2[0], o2[1]); w2.y = cvt_pk_bf16(o2[2], o2[3]); w2.z = cvt_pk_bf16(o2[4], o2[5]); w2.w = cvt_pk_bf16(o2[6], o2[7]);
                    *(u32x4*)(dst + (size_t)j * 256 + cbase) = w1; *(u32x4*)(dst + (size_t)j * 256 + cbase + 128) = w2;
                    if (isk) { tr_write8(tw, m * 16 + fr, fq, w1); w2s[m] = w2; }
                }
                if (isk) {
                    const int jb = ai * 128 + wr * 64 + jg * 8;
                    float zf[8], zb[8];
#pragma unroll
                    for (int i = 0; i < 8; ++i) { zf[i] = EX2(lgf * (float)(255 - jb - i)); zb[i] = EX2(lgb * (float)(jb + i)); }
#pragma unroll
                    for (int grp = 0; grp < 2; ++grp) {
                        if (grp == 1) {
#pragma unroll
                            for (int m = 0; m < 4; ++m) tr_write8(tw, m * 16 + fr, fq, w2s[m]);
                        }
#pragma unroll
                        for (int ps = 0; ps < 4; ++ps) {
                            const int c = ps * 8 + tc; const u32x4 rd = *(const LAS u32x4*)(tw + c * 128 + ((jg ^ ((tc ^ ps) & 7)) << 4));
                            const size_t e = tb + (size_t)(wc * 32 + grp * 128 + c) * 256 + jb;
                            u32x4 a, b;
#pragma unroll
                            for (int t = 0; t < 4; ++t) { const float lo = bflo(rd[t]), hi = bfhi(rd[t]);
                                a[t] = cvt_pk_bf16(lo * zf[2 * t], hi * zf[2 * t + 1]); b[t] = cvt_pk_bf16(lo * zb[2 * t], hi * zb[2 * t + 1]); }
                            __builtin_nontemporal_store(a, (u32x4*)(ktf + e)); __builtin_nontemporal_store(b, (u32x4*)(ktb + e)); }
                    }
                }
            }
        } else {
            const int h = (u.pn - 8) >> 1, eh = ((u.pn - 8) & 1) * 256;
            const size_t tb = ((size_t)(bl * 4 + h) * 16 + chunk) * 131072;
#pragma unroll
            for (int ai = 0; ai < 2; ++ai)
#pragma unroll
                for (int bj = 0; bj < 2; ++bj) {
#pragma unroll
                    for (int m = 0; m < 4; ++m) { const float rs = rsv[ai * 4 + m]; const f32x4 v0 = acc[ai][bj][m][0] * rs, v1 = acc[ai][bj][m][1] * rs;
                        u32x4 w; w.x = cvt_pk_bf16(v0[0], v0[1]); w.y = cvt_pk_bf16(v0[2], v0[3]); w.z = cvt_pk_bf16(v1[0], v1[1]); w.w = cvt_pk_bf16(v1[2], v1[3]);
                        tr_write8(tw, m * 16 + fr, fq, w); }
#pragma unroll
                    for (int ps = 0; ps < 4; ++ps) {
                        const int c = ps * 8 + tc; const u32x4 rd = *(const LAS u32x4*)(tw + c * 128 + ((jg ^ ((tc ^ ps) & 7)) << 4));
                        __builtin_nontemporal_store(rd, (u32x4*)(vtc + tb + (size_t)(eh + bj * 128 + wc * 32 + c) * 256 + ai * 128 + wr * 64 + jg * 8)); }
                }
        }
    }
};
struct EpiScore {
    typedef PreNone Pre;
    __device__ __forceinline__ void pre_load(const Unit& u, int wr, int fr, int fq, Pre& P) const {  }
    static constexpr bool PERM = true, KEEP = false;
    const float* decay; bf16_t* P;
    __device__ __forceinline__ void operator()(f32x4 (&acc)[2][2][4][2], const Unit& u, int wr, int wc, int fr, int fq, const Pre& pre) const {
        const int h = (u.pm >> 4) & 3; const float lgf = lg2sig(decay[h]), lgb = lg2sig(decay[4 + h]);
        bf16_t* dst = P + (size_t)u.pm * 65536;
#pragma unroll
        for (int ai = 0; ai < 2; ++ai)
#pragma unroll
            for (int m = 0; m < 4; ++m) {
                const int a = ai * 128 + wr * 64 + m * 16 + fr;
#pragma unroll
                for (int bj = 0; bj < 2; ++bj) {
                    const int b0 = bj * 128 + wc * 32 + fq * 8; float v[8];
#pragma unroll
                    for (int n = 0; n < 2; ++n)
#pragma unroll
                        for (int jj = 0; jj < 4; ++jj) { const float df = (float)(a - (b0 + n * 4 + jj)); const float dm = EX2(lgf * fmaxf(df, 0.f) + lgb * fmaxf(-df, 0.f)); v[n * 4 + jj] = acc[ai][bj][m][n][jj] * dm; }
                    u32x4 w; w.x = cvt_pk_bf16(v[0], v[1]); w.y = cvt_pk_bf16(v[2], v[3]); w.z = cvt_pk_bf16(v[4], v[5]); w.w = cvt_pk_bf16(v[6], v[7]);
                    *(u32x4*)(dst + (size_t)a * 256 + b0) = w; }
            }
    }
};
struct EpiScan {
    typedef PreNone Pre;
    __device__ __forceinline__ void pre_load(const Unit& u, int wr, int fr, int fq, Pre& P) const {  }
    static constexpr bool PERM = true, KEEP = true;
    bf16_t* rt; int dir; const float* dptr;
    __device__ __forceinline__ void operator()(f32x4 (&acc)[2][2][4][2], const Unit& u, int wr, int wc, int fr, int fq, const Pre& pre) const {
        const float g = EX2(256.f * lg2sig(*dptr));
        const int target = dir ? u.pm - 1 : u.pm + 1;
        if (target >= 0 && target < 16) {
            bf16_t* dst = rt + (size_t)target * 131072;
#pragma unroll
            for (int ai = 0; ai < 2; ++ai)
#pragma unroll
                for (int m = 0; m < 4; ++m) {
                    const int e = ai * 128 + wr * 64 + m * 16 + fr;
#pragma unroll
                    for (int bj = 0; bj < 2; ++bj) { const f32x4 v0 = acc[ai][bj][m][0], v1 = acc[ai][bj][m][1];
                        u32x4 w; w.x = cvt_pk_bf16(v0[0], v0[1]); w.y = cvt_pk_bf16(v0[2], v0[3]); w.z = cvt_pk_bf16(v1[0], v1[1]); w.w = cvt_pk_bf16(v1[2], v1[3]);
                        __builtin_nontemporal_store(w, (u32x4*)(dst + (size_t)e * 256 + bj * 128 + wc * 32 + fq * 8)); }
                }
        }
#pragma unroll
        for (int ai = 0; ai < 2; ++ai)
#pragma unroll
            for (int bj = 0; bj < 2; ++bj)
#pragma unroll
                for (int m = 0; m < 4; ++m)
#pragma unroll
                    for (int n = 0; n < 2; ++n) acc[ai][bj][m][n] *= g;
    }
};
struct EpiOut {
    typedef PreNone Pre;
    __device__ __forceinline__ void pre_load(const Unit& u, int wr, int fr, int fq, Pre& P) const {  }
    static constexpr bool PERM = true, KEEP = true;
    const float* decay; bf16_t* o; float* gst;
    __device__ __forceinline__ void operator()(f32x4 (&acc)[2][2][4][2], const Unit& u, int wr, int wc, int fr, int fq, const Pre& pre) const {
        const int bh = u.pm >> 4, chunk = u.pm & 15, h = bh & 3, bl = bh >> 2;
        const float lgf = lg2sig(decay[h]), lgb = lg2sig(decay[4 + h]);
        const float kf = u.z == 0 ? -lgf : (u.z == 1 ? lgf : 0.f), kb = u.z == 0 ? lgb : 0.f, kz = u.z == 2 ? 0.f : 1.f;
#pragma unroll
        for (int ai = 0; ai < 2; ++ai)
#pragma unroll
            for (int m = 0; m < 4; ++m) {
                const int a = ai * 128 + wr * 64 + m * 16 + fr;
                if (u.z == 2) {
                    const int tl = bl * 4096 + chunk * 256 + a;
                    float s1 = 0.f, s2 = 0.f;
#pragma unroll
                    for (int bj = 0; bj < 2; ++bj) { const f32x4 v0 = acc[ai][bj][m][0], v1 = acc[ai][bj][m][1];
                        s1 += sum4(v0) + sum4(v1); s2 += sum4(v0 * v0) + sum4(v1 * v1);
                        u32x4 w; w.x = cvt_pk_bf16(v0[0], v0[1]); w.y = cvt_pk_bf16(v0[2], v0[3]); w.z = cvt_pk_bf16(v1[0], v1[1]); w.w = cvt_pk_bf16(v1[2], v1[3]);
                        __builtin_nontemporal_store(w, (u32x4*)(o + (size_t)tl * 2048 + h * 512 + u.pn * 256 + bj * 128 + wc * 32 + fq * 8)); }
                    s1 += __shfl_xor(s1, 16); s1 += __shfl_xor(s1, 32); s2 += __shfl_xor(s2, 16); s2 += __shfl_xor(s2, 32);
                    if (fq == 0) *(f32x2*)(gst + (((size_t)tl * 4 + h) * 8 + u.pn * 4 + wc) * 2) = (f32x2){s1, s2};
                }
                const float sc = kz * EX2(kf * (float)(a + 1) + kb * (float)(256 - a));
#pragma unroll
                for (int bj = 0; bj < 2; ++bj)
#pragma unroll
                    for (int n = 0; n < 2; ++n) acc[ai][bj][m][n] *= sc;
                asm volatile("" ::: "memory");
            }
    }
};
struct EpiGate {
    typedef PreRs Pre;
    __device__ __forceinline__ void pre_load(const Unit& u, int wr, int fr, int fq, Pre& P) const { pre_rs(P, ssq, tok0 + u.pm * 256, wr, fr, fq); }
    static constexpr bool PERM = true, KEEP = false;
    const float* ssq; const float* gst; const float* gng; bf16_t* o; int tok0;
    __device__ __forceinline__ void operator()(f32x4 (&acc)[2][2][4][2], const Unit& u, int wr, int wc, int fr, int fq, const Pre& pre) const {
        const int h = u.pn >> 1, c0 = u.pn * 256 + wc * 32 + fq * 8;
        f32x4 gg[2][2];
#pragma unroll
        for (int bj = 0; bj < 2; ++bj) { gg[bj][0] = *(const f32x4*)(gng + c0 + bj * 128); gg[bj][1] = *(const f32x4*)(gng + c0 + bj * 128 + 4); }
        float rsv[8], muv[8], grv[8];
#pragma unroll
        for (int i = 0; i < 8; ++i) {
            const int tl = u.pm * 256 + (i >> 2) * 128 + wr * 64 + (i & 3) * 16 + fr;
            rsv[i] = pre.rs[i];
            const f32x4 st = *(const f32x4*)(gst + ((size_t)tl * 4 + h) * 16 + fq * 4);
            float s1 = st[0] + st[2], s2 = st[1] + st[3];
            s1 += __shfl_xor(s1, 16); s1 += __shfl_xor(s1, 32); s2 += __shfl_xor(s2, 16); s2 += __shfl_xor(s2, 32);
            muv[i] = s1 * (1.f / 512.f); grv[i] = rsqrtf(fmaxf(s2 * (1.f / 512.f) - muv[i] * muv[i], 0.f) + 1e-6f); }
#pragma unroll
        for (int ai = 0; ai < 2; ++ai)
#pragma unroll
            for (int m = 0; m < 4; ++m) {
                const int tl = u.pm * 256 + ai * 128 + wr * 64 + m * 16 + fr;
                if (m == 0) asm volatile("" ::: "memory");
                const float rs = rsv[ai * 4 + m], mu = muv[ai * 4 + m], gr = grv[ai * 4 + m];
#pragma unroll
                for (int bj = 0; bj < 2; ++bj) {
                    bf16_t* op = o + (size_t)tl * 2048 + c0 + bj * 128;
                    const u32x4 ov = *(const u32x4*)op; float y[8];
#pragma unroll
                    for (int n = 0; n < 2; ++n)
#pragma unroll
                        for (int jj = 0; jj < 4; ++jj) { const unsigned w = ov[n * 2 + (jj >> 1)]; const float oval = (jj & 1) ? bfhi(w) : bflo(w);
                            y[n * 4 + jj] = silu_f(acc[ai][bj][m][n][jj] * rs) * gg[bj][n][jj] * (oval - mu) * gr; }
                    u32x4 w; w.x = cvt_pk_bf16(y[0], y[1]); w.y = cvt_pk_bf16(y[2], y[3]); w.z = cvt_pk_bf16(y[4], y[5]); w.w = cvt_pk_bf16(y[6], y[7]);
                    *(u32x4*)op = w; }
            }
    }
};
template <bool GATED> struct EpiResid {
    static constexpr bool PERM = true, KEEP = false;
    typedef PreRs Pre;
    __device__ __forceinline__ void pre_load(const Unit& u, int wr, int fr, int fq, Pre& P) const { if (GATED) pre_rs(P, ssq_in, tok0 + u.pm * 256, wr, fr, fq); }
    const bf16_t* xin; bf16_t* xout; float* ssq_out; const float* ssq_in; const bf16_t* pp; int tok0; float* xf32;
    __device__ __forceinline__ void operator()(f32x4 (&acc)[2][2][4][2], const Unit& u, int wr, int wc, int fr, int fq, const Pre& pre) const {
        const int c0 = u.pn * 256 + wc * 32 + fq * 8;
#pragma unroll
        for (int ai = 0; ai < 2; ++ai) {
            u32x4 pv[4][2];
            if (GATED) {
#pragma unroll
                for (int m = 0; m < 4; ++m)
#pragma unroll
                    for (int bj = 0; bj < 2; ++bj) pv[m][bj] = *(const u32x4*)(pp + (size_t)(tok0 + u.pm * 256 + ai * 128 + wr * 64 + m * 16 + fr) * 1024 + c0 + bj * 128);
            }
#pragma unroll
            for (int m = 0; m < 4; ++m) {
                const int tok = tok0 + u.pm * 256 + ai * 128 + wr * 64 + m * 16 + fr;
                const float nrl = GATED ? -1.4426950408889634f * pre.rs[ai * 4 + m] : 0.f;
                f32x4 ssv = (f32x4){0.f, 0.f, 0.f, 0.f};
#pragma unroll
                for (int bj = 0; bj < 2; ++bj) {
                    const size_t off = (size_t)tok * 1024 + c0 + bj * 128;
                    const u32x4 xv = *(const u32x4*)(xin + off);
                    f32x4 v0 = (f32x4){bflo(xv.x), bfhi(xv.x), bflo(xv.y), bfhi(xv.y)}, v1 = (f32x4){bflo(xv.z), bfhi(xv.z), bflo(xv.w), bfhi(xv.w)};
                    if (GATED) {
                        const u32x4 pw = pv[m][bj];
                        const f32x4 p0 = (f32x4){bflo(pw.x), bfhi(pw.x), bflo(pw.y), bfhi(pw.y)}, p1 = (f32x4){bflo(pw.z), bfhi(pw.z), bflo(pw.w), bfhi(pw.w)};
                        const f32x4 t0 = acc[ai][bj][m][0] * nrl, t1 = acc[ai][bj][m][1] * nrl;
                        f32x4 e0, e1; e0[0] = EX2(t0[0]); e0[1] = EX2(t0[1]); e0[2] = EX2(t0[2]); e0[3] = EX2(t0[3]); e1[0] = EX2(t1[0]); e1[1] = EX2(t1[1]); e1[2] = EX2(t1[2]); e1[3] = EX2(t1[3]);
                        const f32x4 d0 = e0 + 1.0f, d1 = e1 + 1.0f;
                        f32x4 r0, r1; r0[0] = __builtin_amdgcn_rcpf(d0[0]); r0[1] = __builtin_amdgcn_rcpf(d0[1]); r0[2] = __builtin_amdgcn_rcpf(d0[2]); r0[3] = __builtin_amdgcn_rcpf(d0[3]);
                        r1[0] = __builtin_amdgcn_rcpf(d1[0]); r1[1] = __builtin_amdgcn_rcpf(d1[1]); r1[2] = __builtin_amdgcn_rcpf(d1[2]); r1[3] = __builtin_amdgcn_rcpf(d1[3]);
                        v0 += r0 * p0; v1 += r1 * p1; }
                    else { v0 += acc[ai][bj][m][0]; v1 += acc[ai][bj][m][1]; }
                    ssv += v0 * v0; ssv += v1 * v1;
                    if (GATED && xf32) { *(f32x4*)(xf32 + off) = v0; *(f32x4*)(xf32 + off + 4) = v1; }
                    else { u32x4 w; w.x = cvt_pk_bf16(v0[0], v0[1]); w.y = cvt_pk_bf16(v0[2], v0[3]); w.z = cvt_pk_bf16(v1[0], v1[1]); w.w = cvt_pk_bf16(v1[2], v1[3]); *(u32x4*)(xout + off) = w; } }
                float ss = sum4(ssv);
                ss += __shfl_xor(ss, 16); ss += __shfl_xor(ss, 32);
                if (fq == 0) ssq_out[(size_t)tok * 16 + u.pn * 4 + wc] = ss;
            }
            asm volatile("" ::: "memory");
        }
    }
};
struct EpiF1 {
    typedef PreRs Pre;
    __device__ __forceinline__ void pre_load(const Unit& u, int wr, int fr, int fq, Pre& P) const { pre_rs(P, ssq, u.pm * 256, wr, fr, fq); }
    static constexpr bool PERM = true, KEEP = false;
    const float* ssq; bf16_t* H;
    __device__ __forceinline__ void operator()(f32x4 (&acc)[2][2][4][2], const Unit& u, int wr, int wc, int fr, int fq, const Pre& pre) const {
#pragma unroll
        for (int ai = 0; ai < 2; ++ai)
#pragma unroll
            for (int m = 0; m < 4; ++m) {
                const int tok = u.pm * 256 + ai * 128 + wr * 64 + m * 16 + fr;
                const float rs = pre.rs[ai * 4 + m]; const float nrl = -1.4426950408889634f * rs, rs2 = rs * rs; f32x4 hv[2];
#pragma unroll
                for (int n = 0; n < 2; ++n) {
                    const f32x4 g4 = acc[ai][0][m][n], u4 = acc[ai][1][m][n]; const f32x4 t4 = g4 * nrl;
                    f32x4 e4; e4[0] = EX2(t4[0]); e4[1] = EX2(t4[1]); e4[2] = EX2(t4[2]); e4[3] = EX2(t4[3]);
                    const f32x4 d4 = e4 + 1.0f;
                    f32x4 r4; r4[0] = __builtin_amdgcn_rcpf(d4[0]); r4[1] = __builtin_amdgcn_rcpf(d4[1]); r4[2] = __builtin_amdgcn_rcpf(d4[2]); r4[3] = __builtin_amdgcn_rcpf(d4[3]);
                    hv[n] = (g4 * u4) * (r4 * rs2); }
                u32x4 w; w.x = cvt_pk_bf16(hv[0][0], hv[0][1]); w.y = cvt_pk_bf16(hv[0][2], hv[0][3]); w.z = cvt_pk_bf16(hv[1][0], hv[1][1]); w.w = cvt_pk_bf16(hv[1][2], hv[1][3]);
                __builtin_nontemporal_store(w, (u32x4*)(H + (size_t)tok * DFF + u.pn * 128 + wc * 32 + fq * 8));
            }
    }
};
template <bool ZMAP> struct EpiPlain {
    typedef PreNone Pre;
    __device__ __forceinline__ void pre_load(const Unit& u, int wr, int fr, int fq, Pre& P) const {  }
    static constexpr bool PERM = true, KEEP = false;
    bf16_t* C; int ldc;
    __device__ __forceinline__ void operator()(f32x4 (&acc)[2][2][4][2], const Unit& u, int wr, int wc, int fr, int fq, const Pre& pre) const {
#pragma unroll
        for (int ai = 0; ai < 2; ++ai)
#pragma unroll
            for (int m = 0; m < 4; ++m) {
                const int r = u.pm * 256 + ai * 128 + wr * 64 + m * 16 + fr;
                bf16_t* rowp = ZMAP ? C + ((size_t)(u.pn >> 2) * 4096 + r) * 1024 + (u.pn & 3) * 256 : C + (size_t)r * ldc + u.pn * 256;
#pragma unroll
                for (int bj = 0; bj < 2; ++bj) { const f32x4 v0 = acc[ai][bj][m][0], v1 = acc[ai][bj][m][1];
                    u32x4 w; w.x = cvt_pk_bf16(v0[0], v0[1]); w.y = cvt_pk_bf16(v0[2], v0[3]); w.z = cvt_pk_bf16(v1[0], v1[1]); w.w = cvt_pk_bf16(v1[2], v1[3]);
                    *(u32x4*)(rowp + bj * 128 + wc * 32 + fq * 8) = w; }
            }
    }
};
struct Z2Sched {
    const char* D; const char* Z; int G, c;
    __device__ __forceinline__ bool next(int i, Unit& u) const { const int r = i >> 1; if (r * G + c >= 512) return false; const int x = c & 7, y = c >> 3; u.pm = y & 7; u.pn = r * (G >> 3) + x * 4 + (y >> 3); u.z = (i & 1) | (r << 1); return true; }
    __device__ __forceinline__ void ptrs(const Unit& u, const char*& a, const char*& b) const {
        const size_t so = (size_t)(u.z & 1) * 4096;
        a = D + (size_t)u.pm * (256 * 4096 * 2) + so; b = Z + (size_t)u.pn * (256 * 4096 * 2) + so; }
};
struct EpiZ2 {
    typedef PreNone Pre;
    __device__ __forceinline__ void pre_load(const Unit& u, int wr, int fr, int fq, Pre& P) const {  }
    static constexpr bool PERM = true, KEEP = true;
    bf16_t* Fo; float* stash; const bf16_t* nyq;
    __device__ __forceinline__ void operator()(f32x4 (&acc)[2][2][4][2], const Unit& u, int wr, int wc, int fr, int fq, const Pre& pre) const {
        const int tid = (wr * 4 + wc) * 64 + fq * 16 + fr;
        float* st = stash + (size_t)(u.z >> 1) * 65536 + (size_t)tid * 4;
        if ((u.z & 1) == 0) {
#pragma unroll
            for (int ai = 0; ai < 2; ++ai)
#pragma unroll
                for (int m = 0; m < 4; ++m)
#pragma unroll
                    for (int bj = 0; bj < 2; ++bj)
#pragma unroll
                        for (int n = 0; n < 2; ++n) *(f32x4*)(st + (size_t)((((ai * 4 + m) * 2 + bj) * 2 + n) * 2048)) = acc[ai][bj][m][n];
        } else {
            const int b = u.pn >> 2, g = u.pn & 3;
            const float sgn = (fr & 1) ? -1.f : 1.f;
            f32x4 ny[2][2];
#pragma unroll
            for (int bj = 0; bj < 2; ++bj) { const u32x4 nv = *(const u32x4*)(nyq + (size_t)u.pn * 256 + bj * 128 + wc * 32 + fq * 8);
                ny[bj][0] = (f32x4){bflo(nv.x), bfhi(nv.x), bflo(nv.y), bfhi(nv.y)} * sgn; ny[bj][1] = (f32x4){bflo(nv.z), bfhi(nv.z), bflo(nv.w), bfhi(nv.w)} * sgn; }
#pragma unroll
            for (int ai = 0; ai < 2; ++ai)
#pragma unroll
                for (int m = 0; m < 4; ++m) {
                    const int kk = u.pm * 256 + ai * 128 + wr * 64 + m * 16 + fr;
                    bf16_t* r1 = Fo + ((size_t)b * 4096 + kk) * 1024 + g * 256 + wc * 32 + fq * 8;
                    bf16_t* r2 = Fo + ((size_t)b * 4096 + (4096 - kk)) * 1024 + g * 256 + wc * 32 + fq * 8;
#pragma unroll
                    for (int bj = 0; bj < 2; ++bj) {
                        const f32x4 c0 = *(const f32x4*)(st + (size_t)((((ai * 4 + m) * 2 + bj) * 2 + 0) * 2048)) + ny[bj][0], c1 = *(const f32x4*)(st + (size_t)((((ai * 4 + m) * 2 + bj) * 2 + 1) * 2048)) + ny[bj][1];
                        const f32x4 s0 = acc[ai][bj][m][0], s1 = acc[ai][bj][m][1];
                        const f32x4 p0 = c0 + s0, p1 = c1 + s1, q0 = c0 - s0, q1 = c1 - s1;
                        u32x4 w; w.x = cvt_pk_bf16(p0[0], p0[1]); w.y = cvt_pk_bf16(p0[2], p0[3]); w.z = cvt_pk_bf16(p1[0], p1[1]); w.w = cvt_pk_bf16(p1[2], p1[3]);
                        *(u32x4*)(r1 + bj * 128) = w;
                        u32x4 x; x.x = cvt_pk_bf16(q0[0], q0[1]); x.y = cvt_pk_bf16(q0[2], q0[3]); x.z = cvt_pk_bf16(q1[0], q1[1]); x.w = cvt_pk_bf16(q1[2], q1[3]);
                        if (kk != 0) *(u32x4*)(r2 + bj * 128) = x; }
                    if (m & 1) asm volatile("" ::: "memory");
                }
        }
#pragma unroll
        for (int ai = 0; ai < 2; ++ai)
#pragma unroll
            for (int bj = 0; bj < 2; ++bj)
#pragma unroll
                for (int m = 0; m < 4; ++m)
#pragma unroll
                    for (int n = 0; n < 2; ++n) acc[ai][bj][m][n] *= 0.f;
    }
};
struct EpiZ1 {
    typedef PreNone Pre;
    __device__ __forceinline__ void pre_load(const Unit& u, int wr, int fr, int fq, Pre& P) const {  }
    static constexpr bool PERM = true, KEEP = false;
    const float* ssq; bf16_t* zp;
    __device__ __forceinline__ void operator()(f32x4 (&acc)[2][2][4][2], const Unit& u, int wr, int wc, int fr, int fq, const Pre& pre) const {
        const int gg = u.pm >> 1, ri = u.pm & 1, b = u.pn >> 4, s0 = (u.pn & 15) * 256;
        float rs[2][8];
#pragma unroll
        for (int bj = 0; bj < 2; ++bj)
#pragma unroll
            for (int i = 0; i < 8; ++i) { const int tok = u.pn * 256 + bj * 128 + wc * 32 + fq * 8 + i;
                float s = ssq[(size_t)tok * 16 + fr]; s += __shfl_xor(s, 1); s += __shfl_xor(s, 2); s += __shfl_xor(s, 4); s += __shfl_xor(s, 8);
                rs[bj][i] = rsqrtf(s * (1.f / 1024.f) + 1e-6f); }
#pragma unroll
        for (int ai = 0; ai < 2; ++ai)
#pragma unroll
            for (int m = 0; m < 4; ++m) {
                const int l = ai * 128 + wr * 64 + m * 16 + fr;
                bf16_t* rowp = zp + ((size_t)((b * 4 + gg) * 256 + l)) * 8192 + ri * 4096 + s0;
#pragma unroll
                for (int bj = 0; bj < 2; ++bj) { const f32x4 v0 = acc[ai][bj][m][0], v1 = acc[ai][bj][m][1];
                    u32x4 w; w.x = cvt_pk_bf16(v0[0] * rs[bj][0], v0[1] * rs[bj][1]); w.y = cvt_pk_bf16(v0[2] * rs[bj][2], v0[3] * rs[bj][3]);
                    w.z = cvt_pk_bf16(v1[0] * rs[bj][4], v1[1] * rs[bj][5]); w.w = cvt_pk_bf16(v1[2] * rs[bj][6], v1[3] * rs[bj][7]);
                    *(u32x4*)(rowp + bj * 128 + wc * 32 + fq * 8) = w; }
            }
    }
};

__device__ __forceinline__ void conv_wt(const float* __restrict__ W, int K, int N, bf16_t* __restrict__ dst, const float* __restrict__ gain, int mode, int cs_lo, int cs_hi, float cs, size_t gtid, size_t gstride) {
    const size_t total = (size_t)(K / 8) * N;
#pragma unroll 4
    for (size_t idx = gtid; idx < total; idx += gstride) {
        const int n = (int)(idx % N), k0 = (int)(idx / N) * 8; float v[8];
        const float sc = (n >= cs_lo && n < cs_hi) ? cs : 1.f;
#pragma unroll
        for (int j = 0; j < 8; ++j) { v[j] = W[(size_t)(k0 + j) * N + n] * sc; if (gain) v[j] *= gain[k0 + j]; }
        const int drow = mode == 0 ? n : ((n >> 7) * 256 + (mode == 2 ? 128 : 0) + (n & 127));
        u32x4 w; w.x = cvt_pk_bf16(v[0], v[1]); w.y = cvt_pk_bf16(v[2], v[3]); w.z = cvt_pk_bf16(v[4], v[5]); w.w = cvt_pk_bf16(v[6], v[7]);
        *(u32x4*)(dst + (size_t)drow * K + k0) = w;
    }
}

__device__ __forceinline__ void conv_layer_ffn(const Params& p, bf16_t* wb, int i, size_t gtid, size_t gstride) {
    conv_wt(p.w_gate + (size_t)i * 1024 * DFF, 1024, DFF, wb + W_GU + (size_t)i * 5767168, p.norm_ffn + (size_t)i * 1024, 1, 0, 0, 1.f, gtid, gstride);
    conv_wt(p.w_up + (size_t)i * 1024 * DFF, 1024, DFF, wb + W_GU + (size_t)i * 5767168, p.norm_ffn + (size_t)i * 1024, 2, 0, 0, 1.f, gtid, gstride);
    conv_wt(p.w_down + (size_t)i * DFF * 1024, DFF, 1024, wb + W_DN + (size_t)i * 2883584, nullptr, 0, 0, 0, 1.f, gtid, gstride);
    conv_wt(p.ple_wg + (size_t)i * 1048576, 1024, 1024, wb + W_PG + (size_t)i * 1048576, p.norm_ple + (size_t)i * 1024, 0, 0, 0, 1.f, gtid, gstride);
    conv_wt(p.ple_wp + (size_t)i * 262144, 256, 1024, wb + W_PP + (size_t)i * 262144, nullptr, 0, 0, 0, 1.f, gtid, gstride);
}
__device__ __forceinline__ void phase_prep(const Params& p) {
    const size_t gtid = (size_t)blockIdx.x * blockDim.x + threadIdx.x, gstride = (size_t)gridDim.x * blockDim.x;
    bf16_t* wb = (bf16_t*)(p.ws + WS_W);
    for (int j = 0; j < 2; ++j) {
        conv_wt(p.ret_w_in + (size_t)j * 1024 * 6144, 1024, 6144, wb + W_IN + (size_t)j * 6291456, p.norm_mix + (size_t)(2 * j) * 1024, 0, 1024, 2048, 0.0625f, gtid, gstride);
        const float* gain = p.norm_mix + (size_t)(2 * j + 1) * 1024;
        for (size_t idx = gtid; idx < 524288; idx += gstride) { const int c = (int)(idx & 255), np = (int)((idx >> 8) & 511), g = (int)(idx >> 17);
            const float ph = (float)((c * (np & 255)) & 255) * (1.f / 256.f);
            const float v = (np < 256 ? __builtin_amdgcn_cosf(ph) : -__builtin_amdgcn_sinf(ph)) * gain[g * 256 + c] * (1.f / 1024.f);
            wb[W_DFT + (size_t)j * 524288 + idx] = f2bf(v); }
    }
    unsigned* __restrict__ rope = (unsigned*)(p.ws + WS_ROPE); const int* __restrict__ posp = p.pos;
#pragma unroll 4
    for (size_t idx = gtid; idx < (size_t)T * 128; idx += gstride) {
        const int d = (int)(idx & 127); const int tok = (int)(idx >> 7);
        const float freq = 1.0f / exp2f(13.287712379549449f * ((float)d * (1.0f / 127.0f)));
        const float ang = (float)posp[tok] * freq;
        const double rev = (double)ang * 0.15915494309189535; const float fr = (float)(rev - __builtin_rint(rev));
        h16x2 cs; cs.x = (_Float16)__builtin_amdgcn_cosf(fr); cs.y = (_Float16)__builtin_amdgcn_sinf(fr);
        rope[idx] = __builtin_bit_cast(unsigned, cs);
    }
    const int lane = threadIdx.x & 63; const size_t gw = gtid >> 6, nw = gstride >> 6;
    bf16_t* xb = (bf16_t*)p.out; float* ssq = (float*)(p.ws + WS_SSQ);
#pragma unroll 2
    for (size_t row = gw; row < (size_t)T; row += nw) {
        float s = 0.f;
#pragma unroll
        for (int j = 0; j < 4; ++j) { const size_t off = row * 1024 + j * 256 + lane * 4; const f32x4 v = *(const f32x4*)(p.x + off); s += sum4(v * v);
            u32x2 w; w.x = cvt_pk_bf16(v[0], v[1]); w.y = cvt_pk_bf16(v[2], v[3]); *(u32x2*)(xb + off) = w; }
#pragma unroll
        for (int o = 1; o < 64; o <<= 1) s += __shfl_xor(s, o);
        if (lane < 16) ssq[row * 16 + lane] = lane == 0 ? s : 0.f;
    }
}

constexpr size_t WS_BAR = 243 * MiB;
#define XB_TMO      128
#define XB_XCNT(j)  (256  + 64 * (j))
#define XB_XSUB(j)  (1280 + 64 * (j))
#define XB_XGEN(j)  (2304 + 64 * (j))
#define XB_TOP      3328
#define XB_TOPGEN   3392
#define XCD_BAR_WORDS 3456
#define XB_SPIN_CAP (1u << 20)
__device__ __forceinline__ unsigned xb_ld(unsigned* p)              { return __hip_atomic_load(p, __ATOMIC_RELAXED, __HIP_MEMORY_SCOPE_AGENT); }
__device__ __forceinline__ unsigned xb_add(unsigned* p, unsigned v) { return __hip_atomic_fetch_add(p, v, __ATOMIC_RELAXED, __HIP_MEMORY_SCOPE_AGENT); }
__device__ __forceinline__ unsigned xb_xcc_id() { return (unsigned)__builtin_amdgcn_s_getreg((3 << 11) | 20) & 0xFu; }
#define XB_SPIN(cond, bar) do { unsigned _sp = 0; while (cond) { __builtin_amdgcn_s_sleep(1); \
    if ((++_sp & 255u) == 0u) { if (xb_ld(&(bar)[XB_TMO])) break; if (_sp > XB_SPIN_CAP) { atomicAdd(&(bar)[XB_TMO], 1u); break; } } } } while (0)
__device__ __forceinline__ void xcd_census(unsigned* bar, unsigned x, unsigned& nloc, unsigned& nx) {
    const unsigned G = gridDim.x; unsigned sum, cnt, mine, sp = 0u;
    for (;;) {
        sum = 0u; cnt = 0u; mine = 0u;
#pragma unroll
        for (unsigned j = 0; j < 16; ++j) { const unsigned c = xb_ld(&bar[XB_XCNT(j)]); sum += c; cnt += (c > 0u) ? 1u : 0u; mine = (j == x) ? c : mine; }
        if (sum == G) break;
        __builtin_amdgcn_s_sleep(1);
        if ((++sp & 255u) == 0u) { if (xb_ld(&bar[XB_TMO])) break; if (sp > XB_SPIN_CAP) { atomicAdd(&bar[XB_TMO], 1u); break; } }
    }
    nloc = mine > 0u ? mine : 1u; nx = cnt > 0u ? cnt : 1u;
}
__device__ __forceinline__ void grid_bar(unsigned* bar) {
    asm volatile("s_waitcnt vmcnt(0)" ::: "memory");
    __syncthreads();
    if (threadIdx.x == 0) {
        __builtin_amdgcn_s_waitcnt(0);
        const unsigned x = xb_xcc_id();
        unsigned* mine = bar + XCD_BAR_WORDS + 2 * blockIdx.x;
        unsigned nloc = mine[0], nx = mine[1];
        if (nloc == 0u) { xcd_census(bar, x, nloc, nx); mine[0] = nloc; mine[1] = nx; }
        const unsigned old = xb_add(&bar[XB_XSUB(x)], 1u);
        const unsigned gen = old / nloc;
        if (old + 1u == (gen + 1u) * nloc) {
            __builtin_amdgcn_fence(__ATOMIC_RELEASE, "agent");
            asm volatile("s_waitcnt vmcnt(0)" ::: "memory");
            const unsigned og = xb_add(&bar[XB_TOP], 1u);
            const unsigned tg = og / nx;
            if (og + 1u == (tg + 1u) * nx) xb_add(&bar[XB_TOPGEN], 1u);
            else XB_SPIN(xb_ld(&bar[XB_TOPGEN]) == tg, bar);
            __builtin_amdgcn_fence(__ATOMIC_ACQUIRE, "agent");
            xb_add(&bar[XB_XGEN(x)], 1u);
            asm volatile("s_waitcnt vmcnt(0)" ::: "memory");
        } else {
            XB_SPIN(xb_ld(&bar[XB_XGEN(x)]) == gen, bar);
            __builtin_amdgcn_fence(__ATOMIC_ACQUIRE, "agent");
            asm volatile("s_waitcnt vmcnt(0)" ::: "memory");
        }
    }
    __syncthreads();
}

__global__ void __launch_bounds__(512, 2) fwd_kernel(const Params p) {
    extern __shared__ __attribute__((aligned(16))) unsigned char shm[];
    LAS unsigned char* lds = (LAS unsigned char*)shm;
#define gtid ((size_t)blockIdx.x * 512 + (size_t)tidl)
#define gstride ((size_t)gridDim.x * 512)
#define scr (ws + WS_SCR)
#define xb (xsel ? (bf16_t*)outl : (bf16_t*)(ws + WS_XB))
#define xb_oth (xsel ? (bf16_t*)(ws + WS_XB) : (bf16_t*)outl)
#define wb ((bf16_t*)(ws + WS_W))
#define ssq0 ((float*)(ws + WS_SSQ))
#define ssq1 ((float*)(ws + WS_SSQ) + (size_t)T * 16)
#define gst ((float*)(ws + WS_GST))
#define q_b ((bf16_t*)(scr + R_Q))
#define k_b ((bf16_t*)(scr + R_K))
#define ktf_b ((bf16_t*)(scr + R_KTF))
#define ktb_b ((bf16_t*)(scr + R_KTB))
#define vtc_b ((bf16_t*)(scr + R_VTC))
#define P_b ((bf16_t*)(scr + R_P))
#define rf_b ((bf16_t*)(scr + R_RF))
#define rb_b ((bf16_t*)(scr + R_RB))
#define o_b ((bf16_t*)(scr + R_O))
#define zp_b ((bf16_t*)(scr + Z_ZP))
#define F_b ((bf16_t*)(scr + Z_F))
#define dseq_b ((bf16_t*)(scr + Z_D))
#define H_b ((bf16_t*)(scr + F_H))
#define pp_b ((bf16_t*)(scr + F_PP))
#define pb_b ((bf16_t*)(scr + F_PB))
    int ph = 0, nrm = 0, xsel = 1;
#if COOP
    cg::grid_group grid = cg::this_grid();
    if (threadIdx.x == 0) (void)xb_add(&((unsigned*)(p.ws + WS_BAR))[XB_XCNT(xb_xcc_id())], 1u);
#define PH_BEGIN if (ph >= p.ph_lo && ph < p.ph_hi) { size_t zofs = 0; asm volatile("" : "+s"(zofs)); unsigned char* ws = p.ws + zofs; int tidl = threadIdx.x; asm volatile("" : "+v"(tidl)); float* outl = p.out + zofs;
#define PH_END if (ph + 1 < p.ph_hi) { if (p.ph_hi < 0) grid.sync(); else grid_bar((unsigned*)(p.ws + WS_BAR)); } } ++ph;
#else
#define PH_BEGIN if (ph >= p.ph_lo && ph < p.ph_hi) { size_t zofs = 0; asm volatile("" : "+s"(zofs)); unsigned char* ws = p.ws + zofs; int tidl = threadIdx.x; asm volatile("" : "+v"(tidl)); float* outl = p.out + zofs;
#define PH_END } ++ph;
#endif
#define SSQ_CUR ((nrm & 1) ? ssq1 : ssq0)
#define SSQ_NXT ((nrm & 1) ? ssq0 : ssq1)

    PH_BEGIN if (PHSEL(0)) phase_prep(p); PH_END

    for (int layer = 0; layer < 4; ++layer) {
        const int jj = layer >> 1;
        if ((layer & 1) == 0) {
#define decay (p.ret_decay + (size_t)jj * 8)
            for (int hf = 0; hf < 2; ++hf) {
                const int tok0 = hf * TH;
                PH_BEGIN if (PHSEL(1)) {
                    TileSched S; S.init(xb + (size_t)tok0 * 1024, wb + W_IN + (size_t)jj * 6291456, 1024, 1024, 128, 16);
                    EpiR1 E{SSQ_CUR, (const unsigned*)(ws + WS_ROPE), decay, q_b, k_b, ktf_b, ktb_b, vtc_b, tok0, lds + STAGE_BYTES};
                    gemm_phase(lds, S, E, 1024, 1024, 16);
                } PH_END
                PH_BEGIN if (PHSEL(2)) {
                    const int c = blockIdx.x;
#if !defined(SUB) || SUB == 0
                    { const bool act = c < 128; const int item = act ? c : 0, yy = item >> 3, bh = (item & 7) + 8 * (yy >> 2), dir = (yy >> 1) & 1, half = yy & 1, h = bh & 3;
                      bf16_t* rt = (dir ? rb_b : rf_b) + (size_t)bh * 16 * 131072 + (size_t)half * 65536;
                      if (act) { bf16_t* z = rt + (size_t)(dir ? 15 : 0) * 131072; unsigned zz = 0u; asm volatile("" : "+v"(zz)); for (int i = tidl; i < 8192; i += 512) *(u32x4*)(z + (size_t)i * 8) = (u32x4){zz, zz, zz, zz}; }
                      ScanSched S{(const char*)(vtc_b + (size_t)bh * 16 * 131072 + (size_t)half * 65536), (const char*)((dir ? ktb_b : ktf_b) + (size_t)bh * 16 * 65536), dir, act};
                      EpiScan E{rt, dir, decay + dir * 4 + h};
                      gemm_phase(lds, S, E, 256, 256, 4); }
#endif
#if !defined(SUB) || SUB == 1
                    { ScoreSched S{(const char*)q_b, (const char*)k_b, c >= 128 ? c - 128 : -1, (int)gridDim.x - 128};
                      EpiScore E{decay, P_b};
                      gemm_phase(lds, S, E, 256, 256, 4); }
#endif
                    if (c >= 128) {
                        const size_t g2 = (size_t)(c - 128) * 512 + (size_t)tidl, gs2 = (size_t)128 * 512;
                        if (hf == 0) conv_wt(p.ret_w_out + (size_t)jj * 2048 * 1024, 2048, 1024, wb + W_OUT + (size_t)jj * 2097152, nullptr, 0, 0, 0, 1.f, g2, gs2);
                        else         conv_wt(p.fno_w + (size_t)jj * 1048576, 1024, 1024, wb + W_FNO + (size_t)jj * 1048576, nullptr, 0, 0, 0, 1.f, g2, gs2);
                        conv_layer_ffn(p, wb, layer + hf, g2, gs2);
                    }
                } PH_END
                PH_BEGIN if (PHSEL(3)) {
                    OutSched S{(const char*)scr, (int)gridDim.x, (int)blockIdx.x};
                    EpiOut E{decay, o_b, gst};
                    gemm_phase(lds, S, E, 256, 256, 4);
                } PH_END
                PH_BEGIN if (PHSEL(4)) {
                    TileSched S; S.init(xb + (size_t)tok0 * 1024, wb + W_IN + (size_t)jj * 6291456 + (size_t)4096 * 1024, 1024, 1024, 128, 8);
                    EpiGate E{SSQ_CUR, gst, p.ret_gn + (size_t)jj * 2048, o_b, tok0};
                    gemm_phase(lds, S, E, 1024, 1024, 16);
                } PH_END
                PH_BEGIN if (PHSEL(5)) {
                    TileSched S; S.init(o_b, wb + W_OUT + (size_t)jj * 2097152, 2048, 2048, 128, 4);
                    EpiResid<false> E{xb, xb, SSQ_NXT, nullptr, nullptr, tok0, nullptr};
                    gemm_phase(lds, S, E, 2048, 2048, 32);
                } PH_END
            }
            ++nrm;
        } else {
            PH_BEGIN if (PHSEL(6)) {
                for (size_t idx = gtid; idx < (size_t)2048 * 512; idx += gstride) { const int kk = (int)(idx >> 9), c8 = (int)(idx & 511) * 8; const int s0 = c8 & 2047; float v[8];
#pragma unroll
                    for (int i = 0; i < 8; ++i) { const float phs = (float)((kk * (s0 + i)) & 4095) * (1.f / 4096.f); v[i] = c8 < 2048 ? __builtin_amdgcn_cosf(phs) : __builtin_amdgcn_sinf(phs); }
                    u32x4 w; w.x = cvt_pk_bf16(v[0], v[1]); w.y = cvt_pk_bf16(v[2], v[3]); w.z = cvt_pk_bf16(v[4], v[5]); w.w = cvt_pk_bf16(v[6], v[7]);
                    *(u32x4*)(dseq_b + (size_t)kk * 4096 + c8) = w; }
                Z1Sched S{(const char*)(wb + W_DFT + (size_t)jj * 524288), (const char*)xb, (int)gridDim.x, (int)blockIdx.x};
                EpiZ1 E{SSQ_CUR, zp_b};
                gemm_phase(lds, S, E, 256, 1024, 4);
            } PH_END
            PH_BEGIN if (PHSEL(13)) {
                bf16_t* zf = (bf16_t*)(scr + Z_ZF); bf16_t* nyq = (bf16_t*)(scr + Z_NY);
                const int lane = tidl & 63; const size_t gw = gtid >> 6, nw = gstride >> 6;
                for (size_t col = gw; col < 16384; col += nw) { float alt = 0.f;
#pragma unroll 2
                for (int t4 = 0; t4 < 4; ++t4) { const int a = (t4 * 64 + lane) * 8;
                    const bf16_t* zr = zp_b + col * 8192; const bf16_t* zi = zr + 4096;
                    const u32x4 r0 = *(const u32x4*)(zr + a), r1 = *(const u32x4*)(zr + 4088 - a), r2 = *(const u32x4*)(zr + (a ? 4096 - a : 0));
                    const u32x4 i0 = *(const u32x4*)(zi + a), i1 = *(const u32x4*)(zi + 4088 - a), i2 = *(const u32x4*)(zi + (a ? 4096 - a : 0));
                    float dr[8], di[8], mr[8], mi[8];
#pragma unroll
                    for (int j = 0; j < 4; ++j) { dr[2 * j] = bflo(r0[j]); dr[2 * j + 1] = bfhi(r0[j]); di[2 * j] = bflo(i0[j]); di[2 * j + 1] = bfhi(i0[j]); }
#pragma unroll
                    for (int e = 1; e < 8; ++e) { mr[8 - e] = (e & 1) ? bfhi(r1[e >> 1]) : bflo(r1[e >> 1]); mi[8 - e] = (e & 1) ? bfhi(i1[e >> 1]) : bflo(i1[e >> 1]); }
                    mr[0] = a ? bflo(r2[0]) : 0.f; mi[0] = a ? bflo(i2[0]) : 0.f;
                    float er[8], oi[8];
#pragma unroll
                    for (int i = 0; i < 8; ++i) { er[i] = dr[i] + mr[i]; oi[i] = di[i] - mi[i]; }
                    if (a == 0) oi[0] = 0.f;
                    alt += ((er[0] - er[1]) + (er[2] - er[3])) + ((er[4] - er[5]) + (er[6] - er[7]));
                    u32x4 w; w.x = cvt_pk_bf16(er[0], er[1]); w.y = cvt_pk_bf16(er[2], er[3]); w.z = cvt_pk_bf16(er[4], er[5]); w.w = cvt_pk_bf16(er[6], er[7]);
                    *(u32x4*)(zf + col * 4096 + a) = w;
                    u32x4 x; x.x = cvt_pk_bf16(oi[0], oi[1]); x.y = cvt_pk_bf16(oi[2], oi[3]); x.z = cvt_pk_bf16(oi[4], oi[5]); x.w = cvt_pk_bf16(oi[6], oi[7]);
                    *(u32x4*)(zf + col * 4096 + 2048 + a) = x; }
#pragma unroll
                    for (int o2 = 1; o2 < 64; o2 <<= 1) alt += __shfl_xor(alt, o2);
                    if (lane == 0) { const bf16_t zn = zp_b[col * 8192 + 2048]; nyq[col] = zn; F_b[((size_t)(col >> 10) * 4096 + 2048) * 1024 + (col & 1023)] = f2bf(alt + bflo(zn)); } }
            } PH_END
            PH_BEGIN if (PHSEL(7)) {
                Z2Sched S{(const char*)dseq_b, (const char*)(scr + Z_ZF), (int)gridDim.x, (int)blockIdx.x};
                EpiZ2 E{F_b, (float*)(scr + Z_ST) + (size_t)blockIdx.x * 131072, (const bf16_t*)(scr + Z_NY)};
                gemm_phase(lds, S, E, 4096, 4096, 32);
            } PH_END
            PH_BEGIN if (PHSEL(8)) {
                TileSched S; S.init(F_b, wb + W_FNO + (size_t)jj * 1048576, 1024, 1024, 256, 4);
                EpiResid<false> E{xb, xb, SSQ_NXT, nullptr, nullptr, 0, nullptr};
                gemm_phase(lds, S, E, 1024, 1024, 16);
            } PH_END
            ++nrm;
        }
        PH_BEGIN if (PHSEL(9)) {
            TileSched S; S.init(xb, wb + W_GU + (size_t)layer * 5767168, 1024, 1024, 256, 22);
            EpiF1 E{SSQ_CUR, H_b};
            gemm_phase(lds, S, E, 1024, 1024, 16);
            const float* pl = p.p + (size_t)layer * T * 256;
#pragma unroll 4
            for (size_t idx = gtid; idx < (size_t)T * 32; idx += gstride) { const f32x4 a = *(const f32x4*)(pl + idx * 8), b = *(const f32x4*)(pl + idx * 8 + 4);
                u32x4 w; w.x = cvt_pk_bf16(a[0], a[1]); w.y = cvt_pk_bf16(a[2], a[3]); w.z = cvt_pk_bf16(b[0], b[1]); w.w = cvt_pk_bf16(b[2], b[3]); *(u32x4*)(pb_b + idx * 8) = w; }
        } PH_END
        PH_BEGIN if (PHSEL(10)) {
            { TileSched S; S.init(H_b, wb + W_DN + (size_t)layer * 2883584, DFF, DFF, 256, 4);
              EpiResid<false> E{xb, xb, SSQ_NXT, nullptr, nullptr, 0, nullptr};
              gemm_phase(lds, S, E, DFF, DFF, 44); }
            { TileSched S; S.init(pb_b, wb + W_PP + (size_t)layer * 262144, 256, 256, 256, 4);
              EpiPlain<false> E{pp_b, 1024};
              gemm_phase(lds, S, E, 256, 256, 4); }
        } PH_END
        ++nrm;
        PH_BEGIN if (PHSEL(11)) {
            TileSched S; S.init(xb, wb + W_PG + (size_t)layer * 1048576, 1024, 1024, 256, 4);
            EpiResid<true> E{xb, xb_oth, SSQ_NXT, SSQ_CUR, pp_b, 0, layer == 3 ? outl : nullptr};
            gemm_phase(lds, S, E, 1024, 1024, 16);
        } PH_END
        ++nrm; xsel ^= 1;
    }
    PH_BEGIN if (PHSEL(12)) {
        const int lane = tidl & 63; const size_t gw = gtid >> 6, nw = gstride >> 6; const float* ssq = SSQ_CUR;
        for (size_t row = gw; row < (size_t)T; row += nw) {
            float s = lane < 16 ? ssq[row * 16 + lane] : 0.f;
#pragma unroll
            for (int o = 1; o < 16; o <<= 1) s += __shfl_xor(s, o);
            s = __shfl(s, 0);
            const float rs = rsqrtf(s * (1.f / 1024.f) + 1e-6f);
#pragma unroll
            for (int j = 0; j < 4; ++j) { const size_t off = row * 1024 + j * 256 + lane * 4; const f32x4 g = *(const f32x4*)(p.final_norm + j * 256 + lane * 4);
                f32x4 v = *(const f32x4*)(outl + off); v = v * rs * g; *(f32x4*)(outl + off) = v; }
        }
    } PH_END
}

constexpr int LDS_TOTAL = STAGE_BYTES + 32768;
constexpr int N_PHASES = 1 + 2 * (10 + 3) + 2 * (4 + 3) + 1;

extern "C" void kernel_launch(void* const* d_in, const int* in_sizes, int n_in, void* d_out, int out_size, void* d_ws, size_t ws_size, hipStream_t stream) {
    static int ready = 0;
    if (!ready) {
        if (hipFuncSetAttribute((const void*)fwd_kernel, hipFuncAttributeMaxDynamicSharedMemorySize, LDS_TOTAL) != hipSuccess) { fprintf(stderr, "hipFuncSetAttribute failed\n"); ready = -1; return; }
        if (ws_size < 1000 * MiB) { fprintf(stderr, "workspace too small: %zu\n", ws_size); ready = -1; return; }
        ready = 1;
    }
    if (ready < 0) return;
    Params p{};
    p.x = (const float*)d_in[0]; p.p = (const float*)d_in[1]; p.pos = (const int*)d_in[2]; p.norm_mix = (const float*)d_in[3]; p.ret_w_in = (const float*)d_in[4]; p.ret_w_out = (const float*)d_in[5];
    p.ret_gn = (const float*)d_in[6]; p.ret_decay = (const float*)d_in[7]; p.fno_w = (const float*)d_in[8]; p.norm_ffn = (const float*)d_in[9]; p.w_gate = (const float*)d_in[10]; p.w_up = (const float*)d_in[11];
    p.w_down = (const float*)d_in[12]; p.norm_ple = (const float*)d_in[13]; p.ple_wg = (const float*)d_in[14]; p.ple_wp = (const float*)d_in[15]; p.final_norm = (const float*)d_in[16];
    p.out = (float*)d_out; p.ws = (unsigned char*)d_ws;
#if COOP
    p.ph_lo = 0; p.ph_hi = N_PHASES;
    hipMemsetAsync((unsigned char*)d_ws + WS_BAR, 0, (XCD_BAR_WORDS + 2 * 256) * 4, stream);
    void* args[] = {&p};
    hipError_t e = hipLaunchCooperativeKernel((const void*)fwd_kernel, dim3(256), dim3(512), args, LDS_TOTAL, stream);
    if (e != hipSuccess) fprintf(stderr, "cooperative launch failed: %s\n", hipGetErrorString(e));
#else
    for (int ph = 0; ph < N_PHASES; ++ph) { p.ph_lo = ph; p.ph_hi = ph + 1; hipLaunchKernelGGL(fwd_kernel, dim3(256), dim3(512), LDS_TOTAL, stream, p); }
#endif
}
```

```cpp
#include <hip/hip_runtime.h>
#include <hip/hip_cooperative_groups.h>
#include <cstdio>
namespace cg = cooperative_groups;

#define LAS __attribute__((address_space(3)))
typedef unsigned short bf16_t;
typedef short bf16x8 __attribute__((ext_vector_type(8)));
typedef float f32x4 __attribute__((ext_vector_type(4)));
typedef float f32x2 __attribute__((ext_vector_type(2)));
typedef unsigned u32x4 __attribute__((ext_vector_type(4)));
typedef unsigned u32x2 __attribute__((ext_vector_type(2)));
typedef _Float16 h16x2 __attribute__((ext_vector_type(2)));

#ifndef COOP
#define COOP 1
#endif
#ifndef ONLY
#define ONLY -1
#endif
#define EX2(x) __builtin_amdgcn_exp2f(x)
#ifndef EXPDUP
#define EXPDUP -1
#endif
#define PHSEL(k) (ONLY < 0 || ONLY == (k))) for (int rep_ = 0; rep_ < ((EXPDUP) == (k) ? 2 : 1); ++rep_) if ((true)

constexpr int T = 65536, D = 1024, SEQ = 4096, DFF = 2816;
constexpr int TH = 32768;
constexpr size_t MiB = (size_t)1 << 20;
constexpr size_t WS_XB = 0;
constexpr size_t WS_W = 128 * MiB;
constexpr size_t WS_ROPE = 244 * MiB;
constexpr size_t WS_SSQ = 276 * MiB;
constexpr size_t WS_GST = 284 * MiB;
constexpr size_t WS_SCR = 292 * MiB;
constexpr size_t R_Q = 0, R_K = 64 * MiB, R_KTF = 128 * MiB, R_KTB = 192 * MiB, R_VTC = 256 * MiB, R_P = 384 * MiB, R_RF = 448 * MiB, R_RB = 576 * MiB;
constexpr size_t R_O = 64 * MiB;
constexpr size_t F_H = 0, F_PP = 352 * MiB, F_PB = 480 * MiB;
constexpr size_t Z_ZP = 0, Z_F = 256 * MiB, Z_D = 384 * MiB, Z_NY = 416 * MiB, Z_ST = 448 * MiB, Z_ZF = 576 * MiB;
constexpr size_t W_IN = 0;
constexpr size_t W_OUT = W_IN + 2 * 6291456;
constexpr size_t W_FNO = W_OUT + 2 * 2097152;
constexpr size_t W_DFT = W_FNO + 2 * 1048576;
constexpr size_t W_GU = W_DFT + 2 * 524288;
constexpr size_t W_DN = W_GU + 4 * 5767168;
constexpr size_t W_PG = W_DN + 4 * 2883584;
constexpr size_t W_PP = W_PG + 4 * 1048576;

struct Params {
    const float* x; const float* p; const int* pos; const float* norm_mix; const float* ret_w_in; const float* ret_w_out; const float* ret_gn; const float* ret_decay;
    const float* fno_w; const float* norm_ffn; const float* w_gate; const float* w_up; const float* w_down; const float* norm_ple; const float* ple_wg; const float* ple_wp; const float* final_norm;
    float* out; unsigned char* ws; int ph_lo, ph_hi;
};

__device__ __forceinline__ unsigned cvt_pk_bf16(float lo, float hi) { unsigned r; asm("v_cvt_pk_bf16_f32 %0, %1, %2" : "=v"(r) : "v"(lo), "v"(hi)); return r; }
__device__ __forceinline__ bf16_t f2bf(float f) { return (bf16_t)(cvt_pk_bf16(f, 0.f) & 0xffffu); }
__device__ __forceinline__ float bflo(unsigned w) { return __uint_as_float(w << 16); }
__device__ __forceinline__ float bfhi(unsigned w) { return __uint_as_float(w & 0xffff0000u); }
__device__ __forceinline__ float silu_f(float v) { return v * __builtin_amdgcn_rcpf(1.f + __expf(-v)); }
__device__ __forceinline__ float sigmoid_f(float v) { return __builtin_amdgcn_rcpf(1.f + __expf(-v)); }
__device__ __forceinline__ float lg2sig(float logit) { return -__log2f(1.f + __expf(-logit)); }
__device__ __forceinline__ float sum4(f32x4 v) { return (v[0] + v[1]) + (v[2] + v[3]); }
__device__ __forceinline__ float row_rstd(const float* ssq, int tok, int fq) {
    float s = sum4(*(const f32x4*)(ssq + (size_t)tok * 16 + fq * 4));
    s += __shfl_xor(s, 16); s += __shfl_xor(s, 32);
    return rsqrtf(s * (1.f / 1024.f) + 1e-6f);
}

struct PreNone { };
struct PreRs { float rs[8]; };
__device__ __forceinline__ void pre_rs(PreRs& P, const float* ssq, int row0, int wr, int fr, int fq) {
#pragma unroll
    for (int i = 0; i < 8; ++i) P.rs[i] = row_rstd(ssq, row0 + (i >> 2) * 128 + wr * 64 + (i & 3) * 16 + fr, fq);
#pragma unroll
    for (int i = 0; i < 8; ++i) asm volatile("" : "+v"(P.rs[i]));
}

constexpr int BM = 256, BK = 64, HALF = 128, HTB = HALF * BK * 2, STAGE_BYTES = 8 * HTB, NXCD = 8, WGM = 8;
__device__ __forceinline__ int lds_byte(int r, int c) { const int st = (r >> 4) * 2 + (c >> 5), rr = r & 15, cc = c & 31, ob = rr * 64 + cc * 2; return st * 1024 + (ob ^ (((ob >> 9) & 1) << 5)); }
__device__ __forceinline__ void stage_rc(int b, int& R, int& C) { const int st = b / 1024, sb = b % 1024, swz = sb ^ (((sb >> 9) & 1) << 5); R = (st >> 1) * 16 + swz / 64; C = (st & 1) * 32 + (swz % 64) / 2; }
__device__ __forceinline__ int perm32(int rho) { const int n = rho >> 4, i = rho & 15; return 8 * (i >> 2) + 4 * n + (i & 3); }
struct Unit { int pm, pn, z; };
__device__ __forceinline__ const char* uni(const char* p) { const unsigned long long v = (unsigned long long)p; const unsigned lo = __builtin_amdgcn_readfirstlane((unsigned)v), hi = __builtin_amdgcn_readfirstlane((unsigned)(v >> 32)); return (const char*)(((unsigned long long)hi << 32) | lo); }

template <class Epi, class Sched>
__device__ __forceinline__ void gemm_phase(LAS unsigned char* lds, const Sched& S, const Epi& E, const int lda, const int ldb, const int nt) {
    int tid = threadIdx.x; asm volatile("" : "+v"(tid));
    const int wid = __builtin_amdgcn_readfirstlane(tid >> 6), lane = tid & 63, wr = wid >> 2, wc = wid & 3, fr = lane & 15, fq = lane >> 4;
    unsigned voffA[2], voffB[2];
#pragma unroll
    for (int i = 0; i < 2; ++i) { int R, C; stage_rc(tid * 16 + i * 8192, R, C); const int Rb = Epi::PERM ? ((R & ~31) + perm32(R & 31)) : R;
        voffA[i] = (unsigned)(R * lda + C) * 2u; voffB[i] = (unsigned)(Rb * ldb + C) * 2u; }
    const size_t kstep = (size_t)(BK * 2);
    const size_t hstepA = (size_t)HALF * lda * 2, hstepB = (size_t)HALF * ldb * 2;
    const unsigned ldsbase = __builtin_amdgcn_readfirstlane((unsigned)(__UINTPTR_TYPE__)lds + (unsigned)wid * 1024u);
    const int aoff = lds_byte(wr * 64 + fr, fq * 8), boff = lds_byte(wc * 32 + fr, fq * 8);
#define G_SA(b, h) (((b) * 2 + (h)) * HTB)
#define G_SB(b, h) ((4 + (b) * 2 + (h)) * HTB)
#define G_STAGE(bufoff, gbase, voff) do { _Pragma("unroll") for (int _i = 0; _i < 2; ++_i) \
        asm volatile("s_mov_b32 m0, %0\n\ts_nop 0\n\tglobal_load_lds_dwordx4 %1, %2" :: "s"(ldsbase + (unsigned)((bufoff) + _i * 8192)), "v"((voff)[_i]), "s"((const char*)(gbase)) : "m0", "memory"); } while (0)
#define G_LDA(dst, b, h) do { _Pragma("unroll") for (int m = 0; m < 4; ++m) _Pragma("unroll") for (int k = 0; k < 2; ++k) dst[m][k] = *(const LAS bf16x8*)(lds + G_SA(b, h) + aoff + m * 2048 + k * 1024); } while (0)
#define G_LDB(dst, b, h) do { _Pragma("unroll") for (int n = 0; n < 2; ++n) _Pragma("unroll") for (int k = 0; k < 2; ++k) dst[n][k] = *(const LAS bf16x8*)(lds + G_SB(b, h) + boff + n * 2048 + k * 1024); } while (0)
#define G_MMA(ai, bj, At, Bt) do { __builtin_amdgcn_s_setprio(1); _Pragma("unroll") for (int m = 0; m < 4; ++m) _Pragma("unroll") for (int n = 0; n < 2; ++n) _Pragma("unroll") for (int k = 0; k < 2; ++k) \
        acc[ai][bj][m][n] = __builtin_amdgcn_mfma_f32_16x16x32_bf16(Bt[n][k], At[m][k], acc[ai][bj][m][n], 0, 0, 0); __builtin_amdgcn_s_setprio(0); } while (0)
#define G_WAIT_V(n) asm volatile("s_waitcnt vmcnt(" #n ")" ::: "memory")
#define G_WAIT_L(n) asm volatile("s_waitcnt lgkmcnt(" #n ")" ::: "memory")
#define G_BAR __builtin_amdgcn_s_barrier()
#define G_SCHED __builtin_amdgcn_sched_barrier(0)
    Unit cur, nxt; int ui = 0;
    if (!S.next(0, cur)) return;
    f32x4 acc[2][2][4][2];
#pragma unroll
    for (int a = 0; a < 2; ++a)
#pragma unroll
        for (int b = 0; b < 2; ++b)
#pragma unroll
            for (int m = 0; m < 4; ++m)
#pragma unroll
                for (int n = 0; n < 2; ++n) acc[a][b][m][n] = (f32x4){0.f, 0.f, 0.f, 0.f};
    bf16x8 At[4][2], B0[2][2], B1[2][2];
    const char* cA; const char* cB; S.ptrs(cur, cA, cB); cA = uni(cA); cB = uni(cB);
    typename Epi::Pre pre; E.pre_load(cur, wr, fr, fq, pre);
    G_STAGE(G_SB(0, 0), cB, voffB); G_STAGE(G_SA(0, 0), cA, voffA); G_STAGE(G_SB(0, 1), uni(cB + hstepB), voffB); G_STAGE(G_SA(0, 1), uni(cA + hstepA), voffA);
    if (wr == 1) G_BAR;
    G_WAIT_V(4); G_BAR;
    G_STAGE(G_SB(1, 0), uni(cB + kstep), voffB); G_STAGE(G_SA(1, 0), uni(cA + kstep), voffA); G_STAGE(G_SB(1, 1), uni(cB + hstepB + kstep), voffB);
    G_WAIT_V(6); G_BAR;
    for (;;) {
        const bool has_next = S.next(ui + 1, nxt);
        const char* nA = cA; const char* nB = cB; if (has_next) { S.ptrs(nxt, nA, nB); nA = uni(nA); nB = uni(nB); }
        for (int t = 0; t < nt; t += 2) {
            const bool last = (t == nt - 2);
            const char* a1 = uni(cA + (size_t)(t + 1) * kstep);
            const char* a2 = uni(last ? nA : cA + (size_t)(t + 2) * kstep); const char* b2 = uni(last ? nB : cB + (size_t)(t + 2) * kstep);
            const char* a3 = uni(a2 + kstep); const char* b3 = uni(b2 + kstep);
            const char* a1h = uni(a1 + hstepA); const char* a2h = uni(a2 + hstepA); const char* b2h = uni(b2 + hstepB); const char* b3h = uni(b3 + hstepB);
            G_LDB(B0, 0, 0); G_SCHED; G_LDA(At, 0, 0); G_STAGE(G_SA(1, 1), a1h, voffA);
            G_WAIT_L(8); G_BAR; G_WAIT_L(0); G_MMA(0, 0, At, B0); G_BAR; G_SCHED;
            G_LDB(B1, 0, 1); G_STAGE(G_SB(0, 0), b2, voffB);
            G_BAR; G_WAIT_L(0); G_MMA(0, 1, At, B1); G_BAR;
            G_LDA(At, 0, 1); G_STAGE(G_SA(0, 0), a2, voffA);
            G_BAR; G_WAIT_L(0); G_MMA(1, 0, At, B0); G_BAR; G_SCHED;
            G_STAGE(G_SB(0, 1), b2h, voffB);
            G_WAIT_V(6); G_BAR; G_MMA(1, 1, At, B1); G_BAR;
            G_LDB(B0, 1, 0); G_SCHED; G_LDA(At, 1, 0); G_STAGE(G_SA(0, 1), a2h, voffA);
            G_WAIT_L(8); G_BAR; G_WAIT_L(0); G_MMA(0, 0, At, B0); G_BAR; G_SCHED;
            G_LDB(B1, 1, 1); G_STAGE(G_SB(1, 0), b3, voffB);
            G_BAR; G_WAIT_L(0); G_MMA(0, 1, At, B1); G_BAR;
            G_LDA(At, 1, 1); G_STAGE(G_SA(1, 0), a3, voffA);
            G_BAR; G_WAIT_L(0); G_MMA(1, 0, At, B0); G_BAR; G_SCHED;
            G_STAGE(G_SB(1, 1), b3h, voffB);
            G_WAIT_V(6); G_BAR; G_MMA(1, 1, At, B1); G_BAR;
        }
        { int fr_o = fr, fq_o = fq; asm volatile("" : "+v"(fr_o), "+v"(fq_o)); E(acc, cur, wr, wc, fr_o, fq_o, pre); }
        if (!has_next) break;
        if (!Epi::KEEP) {
#pragma unroll
            for (int a = 0; a < 2; ++a)
#pragma unroll
                for (int b = 0; b < 2; ++b)
#pragma unroll
                    for (int m = 0; m < 4; ++m)
#pragma unroll
                        for (int n = 0; n < 2; ++n) acc[a][b][m][n] = (f32x4){0.f, 0.f, 0.f, 0.f};
        }
        cur = nxt; cA = nA; cB = nB; ++ui;
        E.pre_load(cur, wr, fr, fq, pre);
    }
    G_WAIT_V(0);
    if (wr == 0) G_BAR;
    G_BAR;
#undef G_SA
#undef G_SB
#undef G_STAGE
#undef G_LDA
#undef G_LDB
#undef G_MMA
#undef G_WAIT_V
#undef G_WAIT_L
#undef G_BAR
#undef G_SCHED
}

struct TileSched {
    const char* A; const char* B; size_t sA, sB; int nM, nN, nwg, G, c;
    __device__ __forceinline__ void init(const void* A_, const void* B_, int lda, int ldb, int nM_, int nN_) {
        A = (const char*)A_; B = (const char*)B_; sA = (size_t)BM * lda * 2; sB = (size_t)BM * ldb * 2; nM = nM_; nN = nN_; nwg = nM * nN; G = gridDim.x; c = blockIdx.x; }
    __device__ __forceinline__ bool next(int i, Unit& u) const {
        const long L = (long)i * G + c; if (L >= nwg) return false;
        int wgid = (int)L; { const int q = nwg / NXCD, r = nwg % NXCD, xcd = wgid % NXCD, off = wgid / NXCD; wgid = (xcd < r ? xcd * (q + 1) : r * (q + 1) + (xcd - r) * q) + off; }
        const int nig = WGM * nN, gid = wgid / nig, fm = gid * WGM, gsz = (nM - fm) < WGM ? (nM - fm) : WGM;
        u.pm = fm + ((wgid % nig) % gsz); u.pn = (wgid % nig) / gsz; u.z = 0; return true;
    }
    __device__ __forceinline__ void ptrs(const Unit& u, const char*& a, const char*& b) const { a = A + (size_t)u.pm * sA; b = B + (size_t)u.pn * sB; }
};
struct Z1Sched {
    const char* W; const char* X; int G, c;
    __device__ __forceinline__ bool next(int i, Unit& u) const { if (i * G + c >= 2048) return false; const int x = c & 7, y = c >> 3; u.pm = ((x & 3) << 1) | (y & 1); u.pn = i * (G >> 3) + (x >> 2) + 2 * (y >> 1); u.z = 0; return true; }
    __device__ __forceinline__ void ptrs(const Unit& u, const char*& a, const char*& b) const { a = W + (size_t)u.pm * (256 * 256 * 2); b = X + (size_t)u.pn * (256 * 1024 * 2) + (size_t)(u.pm >> 1) * 512; }
};
struct ScanSched {
    const char* vtc; const char* kt; int dir; bool active;
    __device__ __forceinline__ bool next(int i, Unit& u) const { if (!active || i >= 16) return false; u.z = i; u.pm = dir ? 15 - i : i; u.pn = 0; return true; }
    __device__ __forceinline__ void ptrs(const Unit& u, const char*& a, const char*& b) const { a = vtc + (size_t)u.pm * (131072 * 2); b = kt + (size_t)u.pm * (65536 * 2); }
};
struct ScoreSched {
    const char* q; const char* k; int c, stride;
    __device__ __forceinline__ bool next(int i, Unit& u) const { if (c < 0) return false; const int L = i * stride + c; if (L >= 512) return false; u.pm = L; u.pn = 0; u.z = 0; return true; }
    __device__ __forceinline__ void ptrs(const Unit& u, const char*& a, const char*& b) const { a = q + (size_t)u.pm * (65536 * 2); b = k + (size_t)u.pm * (65536 * 2); }
};
struct OutSched {
    const char* scr; int G, c;
    __device__ __forceinline__ bool next(int i, Unit& u) const { const int k = i / 3; if (k * G + c >= 1024) return false; u.pn = (c >> 3) & 1; u.pm = k * (G >> 1) + (c & 7) + 8 * (c >> 4); u.z = i - k * 3; return true; }
    __device__ __forceinline__ void ptrs(const Unit& u, const char*& a, const char*& b) const {
        const size_t ro = ((size_t)u.pm * 512 + (size_t)u.pn * 256) * 256 * 2;
        const size_t z1 = (size_t)(u.z == 1), z2 = (size_t)(u.z == 2);
        a = scr + R_Q + z2 * (R_P - R_Q) + (size_t)u.pm * (65536 * 2);
        b = scr + R_RB - z1 * (R_RB - R_RF) - z2 * (R_RB - R_VTC) + ro; }
};

__device__ __forceinline__ void tr_write8(LAS unsigned char* tw, int r, int fq, const u32x4 w) {
#pragma unroll
    for (int i = 0; i < 8; ++i) { const unsigned v = w[i >> 1];
        *(LAS unsigned short*)(tw + (fq * 8 + i) * 128 + ((((r >> 3) ^ ((i ^ fq) & 7))) << 4) + (r & 7) * 2) = (unsigned short)((i & 1) ? (v >> 16) : (v & 0xffffu)); }
}
struct EpiR1 {
    typedef PreRs Pre;
    __device__ __forceinline__ void pre_load(const Unit& u, int wr, int fr, int fq, Pre& P) const { pre_rs(P, ssq, tok0 + u.pm * 256, wr, fr, fq); }
    static constexpr bool PERM = true, KEEP = false;
    const float* ssq; const unsigned* rope; const float* decay; bf16_t* q; bf16_t* k; bf16_t* ktf; bf16_t* ktb; bf16_t* vtc; int tok0; LAS unsigned char* tl;
    __device__ __forceinline__ void operator()(f32x4 (&acc)[2][2][4][2], const Unit& u, int wr, int wc, int fr, int fq, const Pre& pre) const {
        const int bl = u.pm >> 4, chunk = u.pm & 15, cbase = wc * 32 + fq * 8;
        LAS unsigned char* tw = tl + (wr * 4 + wc) * 4096;
        const int lane = fq * 16 + fr, tc = lane >> 3, jg = lane & 7;
        const float (&rsv)[8] = pre.rs;
        if (u.pn < 8) {
            const bool isk = u.pn >= 4; const int h = u.pn & 3;
            const float lgf = lg2sig(decay[h]), lgb = lg2sig(decay[4 + h]);
            bf16_t* dst = (isk ? k : q) + ((size_t)(bl * 4 + h) * 4096 + chunk * 256) * 256;
            const size_t tb = ((size_t)(bl * 4 + h) * 16 + chunk) * 65536;
#pragma unroll
            for (int ai = 0; ai < 2; ++ai) {
                u32x4 w2s[4];
#pragma unroll
                for (int m = 0; m < 4; ++m) {
                    if (m == 0) asm volatile("" ::: "memory");
                    const int j = ai * 128 + wr * 64 + m * 16 + fr; const int tok = tok0 + u.pm * 256 + j;
                    const float rs = rsv[ai * 4 + m];
                    const u32x4 r0 = *(const u32x4*)(rope + (size_t)tok * 128 + cbase), r1 = *(const u32x4*)(rope + (size_t)tok * 128 + cbase + 4);
                    float o1[8], o2[8];
#pragma unroll
                    for (int n = 0; n < 2; ++n)
#pragma unroll
                        for (int jj = 0; jj < 4; ++jj) {
                            const h16x2 cs = __builtin_bit_cast(h16x2, n == 0 ? r0[jj] : r1[jj]); const float c = (float)cs.x, s = (float)cs.y;
                            const float x1 = acc[ai][0][m][n][jj] * rs, x2 = acc[ai][1][m][n][jj] * rs;
                            o1[n * 4 + jj] = x1 * c - x2 * s; o2[n * 4 + jj] = x1 * s + x2 * c; }
                    u32x4 w1, w2;
                    w1.x = cvt_pk_bf16(o1[0], o1[1]); w1.y = cvt_pk_bf16(o1[2], o1[3]); w1.z = cvt_pk_bf16(o1[4], o1[5]); w1.w = cvt_pk_bf16(o1[6], o1[7]);
                    w2.x = cvt_pk_bf16(o2[0], o2[1]); w2.y = cvt_pk_bf16(o2[2], o2[3]); w2.z = cvt_pk_bf16(o2[4], o2[5]); w2.w = cvt_pk_bf16(o2[6], o2[7]);
                    *(u32x4*)(dst + (size_t)j * 256 + cbase) = w1; *(u32x4*)(dst + (size_t)j * 256 + cbase + 128) = w2;
                    if (isk) { tr_write8(tw, m * 16 + fr, fq, w1); w2s[m] = w2; }
                }
                if (isk) {
                    const int jb = ai * 128 + wr * 64 + jg * 8;
                    float zf[8], zb[8];
#pragma unroll
                    for (int i = 0; i < 8; ++i) { zf[i] = EX2(lgf * (float)(255 - jb - i)); zb[i] = EX2(lgb * (float)(jb + i)); }
#pragma unroll
                    for (int grp = 0; grp < 2; ++grp) {
                        if (grp == 1) {
#pragma unroll
                            for (int m = 0; m < 4; ++m) tr_write8(tw, m * 16 + fr, fq, w2s[m]);
                        }
#pragma unroll
                        for (int ps = 0; ps < 4; ++ps) {
                            const int c = ps * 8 + tc; const u32x4 rd = *(const LAS u32x4*)(tw + c * 128 + ((jg ^ ((tc ^ ps) & 7)) << 4));
                            const size_t e = tb + (size_t)(wc * 32 + grp * 128 + c) * 256 + jb;
                            u32x4 a, b;
#pragma unroll
                            for (int t = 0; t < 4; ++t) { const float lo = bflo(rd[t]), hi = bfhi(rd[t]);
                                a[t] = cvt_pk_bf16(lo * zf[2 * t], hi * zf[2 * t + 1]); b[t] = cvt_pk_bf16(lo * zb[2 * t], hi * zb[2 * t + 1]); }
                            __builtin_nontemporal_store(a, (u32x4*)(ktf + e)); __builtin_nontemporal_store(b, (u32x4*)(ktb + e)); }
                    }
                }
            }
        } else {
            const int h = (u.pn - 8) >> 1, eh = ((u.pn - 8) & 1) * 256;
            const size_t tb = ((size_t)(bl * 4 + h) * 16 + chunk) * 131072;
#pragma unroll
            for (int ai = 0; ai < 2; ++ai)
#pragma unroll
                for (int bj = 0; bj < 2; ++bj) {
#pragma unroll
                    for (int m = 0; m < 4; ++m) { const float rs = rsv[ai * 4 + m]; const f32x4 v0 = acc[ai][bj][m][0] * rs, v1 = acc[ai][bj][m][1] * rs;
                        u32x4 w; w.x = cvt_pk_bf16(v0[0], v0[1]); w.y = cvt_pk_bf16(v0[2], v0[3]); w.z = cvt_pk_bf16(v1[0], v1[1]); w.w = cvt_pk_bf16(v1[2], v1[3]);
                        tr_write8(tw, m * 16 + fr, fq, w); }
#pragma unroll
                    for (int ps = 0; ps < 4; ++ps) {
                        const int c = ps * 8 + tc; const u32x4 rd = *(const LAS u32x4*)(tw + c * 128 + ((jg ^ ((tc ^ ps) & 7)) << 4));
                        __builtin_nontemporal_store(rd, (u32x4*)(vtc + tb + (size_t)(eh + bj * 128 + wc * 32 + c) * 256 + ai * 128 + wr * 64 + jg * 8)); }
                }
        }
    }
};
struct EpiScore {
    typedef PreNone Pre;
    __device__ __forceinline__ void pre_load(const Unit& u, int wr, int fr, int fq, Pre& P) const {  }
    static constexpr bool PERM = true, KEEP = false;
    const float* decay; bf16_t* P;
    __device__ __forceinline__ void operator()(f32x4 (&acc)[2][2][4][2], const Unit& u, int wr, int wc, int fr, int fq, const Pre& pre) const {
        const int h = (u.pm >> 4) & 3; const float lgf = lg2sig(decay[h]), lgb = lg2sig(decay[4 + h]);
        bf16_t* dst = P + (size_t)u.pm * 65536;
#pragma unroll
        for (int ai = 0; ai < 2; ++ai)
#pragma unroll
            for (int m = 0; m < 4; ++m) {
                const int a = ai * 128 + wr * 64 + m * 16 + fr;
#pragma unroll
                for (int bj = 0; bj < 2; ++bj) {
                    const int b0 = bj * 128 + wc * 32 + fq * 8; float v[8];
#pragma unroll
                    for (int n = 0; n < 2; ++n)
#pragma unroll
                        for (int jj = 0; jj < 4; ++jj) { const float df = (float)(a - (b0 + n * 4 + jj)); const float dm = EX2(lgf * fmaxf(df, 0.f) + lgb * fmaxf(-df, 0.f)); v[n * 4 + jj] = acc[ai][bj][m][n][jj] * dm; }
                    u32x4 w; w.x = cvt_pk_bf16(v[0], v[1]); w.y = cvt_pk_bf16(v[2], v[3]); w.z = cvt_pk_bf16(v[4], v[5]); w.w = cvt_pk_bf16(v[6], v[7]);
                    *(u32x4*)(dst + (size_t)a * 256 + b0) = w; }
            }
    }
};
struct EpiScan {
    typedef PreNone Pre;
    __device__ __forceinline__ void pre_load(const Unit& u, int wr, int fr, int fq, Pre& P) const {  }
    static constexpr bool PERM = true, KEEP = true;
    bf16_t* rt; int dir; const float* dptr;
    __device__ __forceinline__ void operator()(f32x4 (&acc)[2][2][4][2], const Unit& u, int wr, int wc, int fr, int fq, const Pre& pre) const {
        const float g = EX2(256.f * lg2sig(*dptr));
        const int target = dir ? u.pm - 1 : u.pm + 1;
        if (target >= 0 && target < 16) {
            bf16_t* dst = rt + (size_t)target * 131072;
#pragma unroll
            for (int ai = 0; ai < 2; ++ai)
#pragma unroll
                for (int m = 0; m < 4; ++m) {
                    const int e = ai * 128 + wr * 64 + m * 16 + fr;
#pragma unroll
                    for (int bj = 0; bj < 2; ++bj) { const f32x4 v0 = acc[ai][bj][m][0], v1 = acc[ai][bj][m][1];
                        u32x4 w; w.x = cvt_pk_bf16(v0[0], v0[1]); w.y = cvt_pk_bf16(v0[2], v0[3]); w.z = cvt_pk_bf16(v1[0], v1[1]); w.w = cvt_pk_bf16(v1[2], v1[3]);
                        __builtin_nontemporal_store(w, (u32x4*)(dst + (size_t)e * 256 + bj * 128 + wc * 32 + fq * 8)); }
                }
        }
#pragma unroll
        for (int ai = 0; ai < 2; ++ai)
#pragma unroll
            for (int bj = 0; bj < 2; ++bj)
#pragma unroll
                for (int m = 0; m < 4; ++m)
#pragma unroll
                    for (int n = 0; n < 2; ++n) acc[ai][bj][m][n] *= g;
    }
};
struct EpiOut {
    typedef PreNone Pre;
    __device__ __forceinline__ void pre_load(const Unit& u, int wr, int fr, int fq, Pre& P) const {  }
    static constexpr bool PERM = true, KEEP = true;
    const float* decay; bf16_t* o; float* gst;
    __device__ __forceinline__ void operator()(f32x4 (&acc)[2][2][4][2], const Unit& u, int wr, int wc, int fr, int fq, const Pre& pre) const {
        const int bh = u.pm >> 4, chunk = u.pm & 15, h = bh & 3, bl = bh >> 2;
        const float lgf = lg2sig(decay[h]), lgb = lg2sig(decay[4 + h]);
        const float kf = u.z == 0 ? -lgf : (u.z == 1 ? lgf : 0.f), kb = u.z == 0 ? lgb : 0.f, kz = u.z == 2 ? 0.f : 1.f;
#pragma unroll
        for (int ai = 0; ai < 2; ++ai)
#pragma unroll
            for (int m = 0; m < 4; ++m) {
                const int a = ai * 128 + wr * 64 + m * 16 + fr;
                if (u.z == 2) {
                    const int tl = bl * 4096 + chunk * 256 + a;
                    float s1 = 0.f, s2 = 0.f;
#pragma unroll
                    for (int bj = 0; bj < 2; ++bj) { const f32x4 v0 = acc[ai][bj][m][0], v1 = acc[ai][bj][m][1];
                        s1 += sum4(v0) + sum4(v1); s2 += sum4(v0 * v0) + sum4(v1 * v1);
                        u32x4 w; w.x = cvt_pk_bf16(v0[0], v0[1]); w.y = cvt_pk_bf16(v0[2], v0[3]); w.z = cvt_pk_bf16(v1[0], v1[1]); w.w = cvt_pk_bf16(v1[2], v1[3]);
                        __builtin_nontemporal_store(w, (u32x4*)(o + (size_t)tl * 2048 + h * 512 + u.pn * 256 + bj * 128 + wc * 32 + fq * 8)); }
                    s1 += __shfl_xor(s1, 16); s1 += __shfl_xor(s1, 32); s2 += __shfl_xor(s2, 16); s2 += __shfl_xor(s2, 32);
                    if (fq == 0) *(f32x2*)(gst + (((size_t)tl * 4 + h) * 8 + u.pn * 4 + wc) * 2) = (f32x2){s1, s2};
                }
                const float sc = kz * EX2(kf * (float)(a + 1) + kb * (float)(256 - a));
#pragma unroll
                for (int bj = 0; bj < 2; ++bj)
#pragma unroll
                    for (int n = 0; n < 2; ++n) acc[ai][bj][m][n] *= sc;
                asm volatile("" ::: "memory");
            }
    }
};
struct EpiGate {
    typedef PreRs Pre;
    __device__ __forceinline__ void pre_load(const Unit& u, int wr, int fr, int fq, Pre& P) const { pre_rs(P, ssq, tok0 + u.pm * 256, wr, fr, fq); }
    static constexpr bool PERM = true, KEEP = false;
    const float* ssq; const float* gst; const float* gng; bf16_t* o; int tok0;
    __device__ __forceinline__ void operator()(f32x4 (&acc)[2][2][4][2], const Unit& u, int wr, int wc, int fr, int fq, const Pre& pre) const {
        const int h = u.pn >> 1, c0 = u.pn * 256 + wc * 32 + fq * 8;
        f32x4 gg[2][2];
#pragma unroll
        for (int bj = 0; bj < 2; ++bj) { gg[bj][0] = *(const f32x4*)(gng + c0 + bj * 128); gg[bj][1] = *(const f32x4*)(gng + c0 + bj * 128 + 4); }
        float rsv[8], muv[8], grv[8];
#pragma unroll
        for (int i = 0; i < 8; ++i) {
            const int tl = u.pm * 256 + (i >> 2) * 128 + wr * 64 + (i & 3) * 16 + fr;
            rsv[i] = pre.rs[i];
            const f32x4 st = *(const f32x4*)(gst + ((size_t)tl * 4 + h) * 16 + fq * 4);
            float s1 = st[0] + st[2], s2 = st[1] + st[3];
            s1 += __shfl_xor(s1, 16); s1 += __shfl_xor(s1, 32); s2 += __shfl_xor(s2, 16); s2 += __shfl_xor(s2, 32);
            muv[i] = s1 * (1.f / 512.f); grv[i] = rsqrtf(fmaxf(s2 * (1.f / 512.f) - muv[i] * muv[i], 0.f) + 1e-6f); }
#pragma unroll
        for (int ai = 0; ai < 2; ++ai)
#pragma unroll
            for (int m = 0; m < 4; ++m) {
                const int tl = u.pm * 256 + ai * 128 + wr * 64 + m * 16 + fr;
                if (m == 0) asm volatile("" ::: "memory");
                const float rs = rsv[ai * 4 + m], mu = muv[ai * 4 + m], gr = grv[ai * 4 + m];
#pragma unroll
                for (int bj = 0; bj < 2; ++bj) {
                    bf16_t* op = o + (size_t)tl * 2048 + c0 + bj * 128;
                    const u32x4 ov = *(const u32x4*)op; float y[8];
#pragma unroll
                    for (int n = 0; n < 2; ++n)
#pragma unroll
                        for (int jj = 0; jj < 4; ++jj) { const unsigned w = ov[n * 2 + (jj >> 1)]; const float oval = (jj & 1) ? bfhi(w) : bflo(w);
                            y[n * 4 + jj] = silu_f(acc[ai][bj][m][n][jj] * rs) * gg[bj][n][jj] * (oval - mu) * gr; }
                    u32x4 w; w.x = cvt_pk_bf16(y[0], y[1]); w.y = cvt_pk_bf16(y[2], y[3]); w.z = cvt_pk_bf16(y[4], y[5]); w.w = cvt_pk_bf16(y[6], y[7]);
                    *(u32x4*)op = w; }
            }
    }
};
template <bool GATED> struct EpiResid {
    static constexpr bool PERM = true, KEEP = false;
    typedef PreRs Pre;
    __device__ __forceinline__ void pre_load(const Unit& u, int wr, int fr, int fq, Pre& P) const { if (GATED) pre_rs(P, ssq_in, tok0 + u.pm * 256, wr, fr, fq); }
    const bf16_t* xin; bf16_t* xout; float* ssq_out; const float* ssq_in; const bf16_t* pp; int tok0; float* xf32;
    __device__ __forceinline__ void operator()(f32x4 (&acc)[2][2][4][2], const Unit& u, int wr, int wc, int fr, int fq, const Pre& pre) const {
        const int c0 = u.pn * 256 + wc * 32 + fq * 8;
#pragma unroll
        for (int ai = 0; ai < 2; ++ai) {
            u32x4 pv[4][2];
            if (GATED) {
#pragma unroll
                for (int m = 0; m < 4; ++m)
#pragma unroll
                    for (int bj = 0; bj < 2; ++bj) pv[m][bj] = *(const u32x4*)(pp + (size_t)(tok0 + u.pm * 256 + ai * 128 + wr * 64 + m * 16 + fr) * 1024 + c0 + bj * 128);
            }
#pragma unroll
            for (int m = 0; m < 4; ++m) {
                const int tok = tok0 + u.pm * 256 + ai * 128 + wr * 64 + m * 16 + fr;
                const float nrl = GATED ? -1.4426950408889634f * pre.rs[ai * 4 + m] : 0.f;
                f32x4 ssv = (f32x4){0.f, 0.f, 0.f, 0.f};
#pragma unroll
                for (int bj = 0; bj < 2; ++bj) {
                    const size_t off = (size_t)tok * 1024 + c0 + bj * 128;
                    const u32x4 xv = *(const u32x4*)(xin + off);
                    f32x4 v0 = (f32x4){bflo(xv.x), bfhi(xv.x), bflo(xv.y), bfhi(xv.y)}, v1 = (f32x4){bflo(xv.z), bfhi(xv.z), bflo(xv.w), bfhi(xv.w)};
                    if (GATED) {
                        const u32x4 pw = pv[m][bj];
                        const f32x4 p0 = (f32x4){bflo(pw.x), bfhi(pw.x), bflo(pw.y), bfhi(pw.y)}, p1 = (f32x4){bflo(pw.z), bfhi(pw.z), bflo(pw.w), bfhi(pw.w)};
                        const f32x4 t0 = acc[ai][bj][m][0] * nrl, t1 = acc[ai][bj][m][1] * nrl;
                        f32x4 e0, e1; e0[0] = EX2(t0[0]); e0[1] = EX2(t0[1]); e0[2] = EX2(t0[2]); e0[3] = EX2(t0[3]); e1[0] = EX2(t1[0]); e1[1] = EX2(t1[1]); e1[2] = EX2(t1[2]); e1[3] = EX2(t1[3]);
                        const f32x4 d0 = e0 + 1.0f, d1 = e1 + 1.0f;
                        f32x4 r0, r1; r0[0] = __builtin_amdgcn_rcpf(d0[0]); r0[1] = __builtin_amdgcn_rcpf(d0[1]); r0[2] = __builtin_amdgcn_rcpf(d0[2]); r0[3] = __builtin_amdgcn_rcpf(d0[3]);
                        r1[0] = __builtin_amdgcn_rcpf(d1[0]); r1[1] = __builtin_amdgcn_rcpf(d1[1]); r1[2] = __builtin_amdgcn_rcpf(d1[2]); r1[3] = __builtin_amdgcn_rcpf(d1[3]);
                        v0 += r0 * p0; v1 += r1 * p1; }
                    else { v0 += acc[ai][bj][m][0]; v1 += acc[ai][bj][m][1]; }
                    ssv += v0 * v0; ssv += v1 * v1;
                    if (GATED && xf32) { *(f32x4*)(xf32 + off) = v0; *(f32x4*)(xf32 + off + 4) = v1; }
                    else { u32x4 w; w.x = cvt_pk_bf16(v0[0], v0[1]); w.y = cvt_pk_bf16(v0[2], v0[3]); w.z = cvt_pk_bf16(v1[0], v1[1]); w.w = cvt_pk_bf16(v1[2], v1[3]); *(u32x4*)(xout + off) = w; } }
                float ss = sum4(ssv);
                ss += __shfl_xor(ss, 16); ss += __shfl_xor(ss, 32);
                if (fq == 0) ssq_out[(size_t)tok * 16 + u.pn * 4 + wc] = ss;
            }
            asm volatile("" ::: "memory");
        }
    }
};
struct EpiF1 {
    typedef PreRs Pre;
    __device__ __forceinline__ void pre_load(const Unit& u, int wr, int fr, int fq, Pre& P) const { pre_rs(P, ssq, u.pm * 256, wr, fr, fq); }
    static constexpr bool PERM = true, KEEP = false;
    const float* ssq; bf16_t* H;
    __device__ __forceinline__ void operator()(f32x4 (&acc)[2][2][4][2], const Unit& u, int wr, int wc, int fr, int fq, const Pre& pre) const {
#pragma unroll
        for (int ai = 0; ai < 2; ++ai)
#pragma unroll
            for (int m = 0; m < 4; ++m) {
                const int tok = u.pm * 256 + ai * 128 + wr * 64 + m * 16 + fr;
                const float rs = pre.rs[ai * 4 + m]; const float nrl = -1.4426950408889634f * rs, rs2 = rs * rs; f32x4 hv[2];
#pragma unroll
                for (int n = 0; n < 2; ++n) {
                    const f32x4 g4 = acc[ai][0][m][n], u4 = acc[ai][1][m][n]; const f32x4 t4 = g4 * nrl;
                    f32x4 e4; e4[0] = EX2(t4[0]); e4[1] = EX2(t4[1]); e4[2] = EX2(t4[2]); e4[3] = EX2(t4[3]);
                    const f32x4 d4 = e4 + 1.0f;
                    f32x4 r4; r4[0] = __builtin_amdgcn_rcpf(d4[0]); r4[1] = __builtin_amdgcn_rcpf(d4[1]); r4[2] = __builtin_amdgcn_rcpf(d4[2]); r4[3] = __builtin_amdgcn_rcpf(d4[3]);
                    hv[n] = (g4 * u4) * (r4 * rs2); }
                u32x4 w; w.x = cvt_pk_bf16(hv[0][0], hv[0][1]); w.y = cvt_pk_bf16(hv[0][2], hv[0][3]); w.z = cvt_pk_bf16(hv[1][0], hv[1][1]); w.w = cvt_pk_bf16(hv[1][2], hv[1][3]);
                __builtin_nontemporal_store(w, (u32x4*)(H + (size_t)tok * DFF + u.pn * 128 + wc * 32 + fq * 8));
            }
    }
};
template <bool ZMAP> struct EpiPlain {
    typedef PreNone Pre;
    __device__ __forceinline__ void pre_load(const Unit& u, int wr, int fr, int fq, Pre& P) const {  }
    static constexpr bool PERM = true, KEEP = false;
    bf16_t* C; int ldc;
    __device__ __forceinline__ void operator()(f32x4 (&acc)[2][2][4][2], const Unit& u, int wr, int wc, int fr, int fq, const Pre& pre) const {
#pragma unroll
        for (int ai = 0; ai < 2; ++ai)
#pragma unroll
            for (int m = 0; m < 4; ++m) {
                const int r = u.pm * 256 + ai * 128 + wr * 64 + m * 16 + fr;
                bf16_t* rowp = ZMAP ? C + ((size_t)(u.pn >> 2) * 4096 + r) * 1024 + (u.pn & 3) * 256 : C + (size_t)r * ldc + u.pn * 256;
#pragma unroll
                for (int bj = 0; bj < 2; ++bj) { const f32x4 v0 = acc[ai][bj][m][0], v1 = acc[ai][bj][m][1];
                    u32x4 w; w.x = cvt_pk_bf16(v0[0], v0[1]); w.y = cvt_pk_bf16(v0[2], v0[3]); w.z = cvt_pk_bf16(v1[0], v1[1]); w.w = cvt_pk_bf16(v1[2], v1[3]);
                    *(u32x4*)(rowp + bj * 128 + wc * 32 + fq * 8) = w; }
            }
    }
};
struct Z2Sched {
    const char* D; const char* Z; int G, c;
    __device__ __forceinline__ bool next(int i, Unit& u) const { const int r = i >> 1; if (r * G + c >= 512) return false; const int x = c & 7, y = c >> 3; u.pm = y & 7; u.pn = r * (G >> 3) + x * 4 + (y >> 3); u.z = (i & 1) | (r << 1); return true; }
    __device__ __forceinline__ void ptrs(const Unit& u, const char*& a, const char*& b) const {
        const size_t so = (size_t)(u.z & 1) * 4096;
        a = D + (size_t)u.pm * (256 * 4096 * 2) + so; b = Z + (size_t)u.pn * (256 * 4096 * 2) + so; }
};
struct EpiZ2 {
    typedef PreNone Pre;
    __device__ __forceinline__ void pre_load(const Unit& u, int wr, int fr, int fq, Pre& P) const {  }
    static constexpr bool PERM = true, KEEP = true;
    bf16_t* Fo; float* stash; const bf16_t* nyq;
    __device__ __forceinline__ void operator()(f32x4 (&acc)[2][2][4][2], const Unit& u, int wr, int wc, int fr, int fq, const Pre& pre) const {
        const int tid = (wr * 4 + wc) * 64 + fq * 16 + fr;
        float* st = stash + (size_t)(u.z >> 1) * 65536 + (size_t)tid * 4;
        if ((u.z & 1) == 0) {
#pragma unroll
            for (int ai = 0; ai < 2; ++ai)
#pragma unroll
                for (int m = 0; m < 4; ++m)
#pragma unroll
                    for (int bj = 0; bj < 2; ++bj)
#pragma unroll
                        for (int n = 0; n < 2; ++n) *(f32x4*)(st + (size_t)((((ai * 4 + m) * 2 + bj) * 2 + n) * 2048)) = acc[ai][bj][m][n];
        } else {
            const int b = u.pn >> 2, g = u.pn & 3;
            const float sgn = (fr & 1) ? -1.f : 1.f;
            f32x4 ny[2][2];
#pragma unroll
            for (int bj = 0; bj < 2; ++bj) { const u32x4 nv = *(const u32x4*)(nyq + (size_t)u.pn * 256 + bj * 128 + wc * 32 + fq * 8);
                ny[bj][0] = (f32x4){bflo(nv.x), bfhi(nv.x), bflo(nv.y), bfhi(nv.y)} * sgn; ny[bj][1] = (f32x4){bflo(nv.z), bfhi(nv.z), bflo(nv.w), bfhi(nv.w)} * sgn; }
#pragma unroll
            for (int ai = 0; ai < 2; ++ai)
#pragma unroll
                for (int m = 0; m < 4; ++m) {
                    const int kk = u.pm * 256 + ai * 128 + wr * 64 + m * 16 + fr;
                    bf16_t* r1 = Fo + ((size_t)b * 4096 + kk) * 1024 + g * 256 + wc * 32 + fq * 8;
                    bf16_t* r2 = Fo + ((size_t)b * 4096 + (4096 - kk)) * 1024 + g * 256 + wc * 32 + fq * 8;
#pragma unroll
                    for (int bj = 0; bj < 2; ++bj) {
                        const f32x4 c0 = *(const f32x4*)(st + (size_t)((((ai * 4 + m) * 2 + bj) * 2 + 0) * 2048)) + ny[bj][0], c1 = *(const f32x4*)(st + (size_t)((((ai * 4 + m) * 2 + bj) * 2 + 1) * 2048)) + ny[bj][1];
                        const f32x4 s0 = acc[ai][bj][m][0], s1 = acc[ai][bj][m][1];
                        const f32x4 p0 = c0 + s0, p1 = c1 + s1, q0 = c0 - s0, q1 = c1 - s1;
                        u32x4 w; w.x = cvt_pk_bf16(p0[0], p0[1]); w.y = cvt_pk_bf16(p0[2], p0[3]); w.z = cvt_pk_bf16(p1[0], p1[1]); w.w = cvt_pk_bf16(p1[2], p1[3]);
                        *(u32x4*)(r1 + bj * 128) = w;
                        u32x4 x; x.x = cvt_pk_bf16(q0[0], q0[1]); x.y = cvt_pk_bf16(q0[2], q0[3]); x.z = cvt_pk_bf16(q1[0], q1[1]); x.w = cvt_pk_bf16(q1[2], q1[3]);
                        if (kk != 0) *(u32x4*)(r2 + bj * 128) = x; }
                    if (m & 1) asm volatile("" ::: "memory");
                }
        }
#pragma unroll
        for (int ai = 0; ai < 2; ++ai)
#pragma unroll
            for (int bj = 0; bj < 2; ++bj)
#pragma unroll
                for (int m = 0; m < 4; ++m)
#pragma unroll
                    for (int n = 0; n < 2; ++n) acc[ai][bj][m][n] *= 0.f;
    }
};
struct EpiZ1 {
    typedef PreNone Pre;
    __device__ __forceinline__ void pre_load(const Unit& u, int wr, int fr, int fq, Pre& P) const {  }
    static constexpr bool PERM = true, KEEP = false;
    const float* ssq; bf16_t* zp;
    __device__ __forceinline__ void operator()(f32x4 (&acc)[2][2][4][2], const Unit& u, int wr, int wc, int fr, int fq, const Pre& pre) const {
        const int gg = u.pm >> 1, ri = u.pm & 1, b = u.pn >> 4, s0 = (u.pn & 15) * 256;
        float rs[2][8];
#pragma unroll
        for (int bj = 0; bj < 2; ++bj)
#pragma unroll
            for (int i = 0; i < 8; ++i) { const int tok = u.pn * 256 + bj * 128 + wc * 32 + fq * 8 + i;
                float s = ssq[(size_t)tok * 16 + fr]; s += __shfl_xor(s, 1); s += __shfl_xor(s, 2); s += __shfl_xor(s, 4); s += __shfl_xor(s, 8);
                rs[bj][i] = rsqrtf(s * (1.f / 1024.f) + 1e-6f); }
#pragma unroll
        for (int ai = 0; ai < 2; ++ai)
#pragma unroll
            for (int m = 0; m < 4; ++m) {
                const int l = ai * 128 + wr * 64 + m * 16 + fr;
                bf16_t* rowp = zp + ((size_t)((b * 4 + gg) * 256 + l)) * 8192 + ri * 4096 + s0;
#pragma unroll
                for (int bj = 0; bj < 2; ++bj) { const f32x4 v0 = acc[ai][bj][m][0], v1 = acc[ai][bj][m][1];
                    u32x4 w; w.x = cvt_pk_bf16(v0[0] * rs[bj][0], v0[1] * rs[bj][1]); w.y = cvt_pk_bf16(v0[2] * rs[bj][2], v0[3] * rs[bj][3]);
                    w.z = cvt_pk_bf16(v1[0] * rs[bj][4], v1[1] * rs[bj][5]); w.w = cvt_pk_bf16(v1[2] * rs[bj][6], v1[3] * rs[bj][7]);
                    *(u32x4*)(rowp + bj * 128 + wc * 32 + fq * 8) = w; }
            }
    }
};

__device__ __forceinline__ void conv_wt(const float* __restrict__ W, int K, int N, bf16_t* __restrict__ dst, const float* __restrict__ gain, int mode, int cs_lo, int cs_hi, float cs, size_t gtid, size_t gstride) {
    const size_t total = (size_t)(K / 8) * N;
#pragma unroll 4
    for (size_t idx = gtid; idx < total; idx += gstride) {
        const int n = (int)(idx % N), k0 = (int)(idx / N) * 8; float v[8];
        const float sc = (n >= cs_lo && n < cs_hi) ? cs : 1.f;
#pragma unroll
        for (int j = 0; j < 8; ++j) { v[j] = W[(size_t)(k0 + j) * N + n] * sc; if (gain) v[j] *= gain[k0 + j]; }
        const int drow = mode == 0 ? n : ((n >> 7) * 256 + (mode == 2 ? 128 : 0) + (n & 127));
        u32x4 w; w.x = cvt_pk_bf16(v[0], v[1]); w.y = cvt_pk_bf16(v[2], v[3]); w.z = cvt_pk_bf16(v[4], v[5]); w.w = cvt_pk_bf16(v[6], v[7]);
        *(u32x4*)(dst + (size_t)drow * K + k0) = w;
    }
}

__device__ __forceinline__ void conv_layer_ffn(const Params& p, bf16_t* wb, int i, size_t gtid, size_t gstride) {
    conv_wt(p.w_gate + (size_t)i * 1024 * DFF, 1024, DFF, wb + W_GU + (size_t)i * 5767168, p.norm_ffn + (size_t)i * 1024, 1, 0, 0, 1.f, gtid, gstride);
    conv_wt(p.w_up + (size_t)i * 1024 * DFF, 1024, DFF, wb + W_GU + (size_t)i * 5767168, p.norm_ffn + (size_t)i * 1024, 2, 0, 0, 1.f, gtid, gstride);
    conv_wt(p.w_down + (size_t)i * DFF * 1024, DFF, 1024, wb + W_DN + (size_t)i * 2883584, nullptr, 0, 0, 0, 1.f, gtid, gstride);
    conv_wt(p.ple_wg + (size_t)i * 1048576, 1024, 1024, wb + W_PG + (size_t)i * 1048576, p.norm_ple + (size_t)i * 1024, 0, 0, 0, 1.f, gtid, gstride);
    conv_wt(p.ple_wp + (size_t)i * 262144, 256, 1024, wb + W_PP + (size_t)i * 262144, nullptr, 0, 0, 0, 1.f, gtid, gstride);
}
__device__ __forceinline__ void phase_prep(const Params& p) {
    const size_t gtid = (size_t)blockIdx.x * blockDim.x + threadIdx.x, gstride = (size_t)gridDim.x * blockDim.x;
    bf16_t* wb = (bf16_t*)(p.ws + WS_W);
    for (int j = 0; j < 2; ++j) {
        if (j == 0) conv_wt(p.ret_w_in, 1024, 6144, wb + W_IN, p.norm_mix, 0, 1024, 2048, 0.0625f, gtid, gstride);
        const float* gain = p.norm_mix + (size_t)(2 * j + 1) * 1024;
        for (size_t idx = gtid; idx < 524288; idx += gstride) { const int c = (int)(idx & 255), np = (int)((idx >> 8) & 511), g = (int)(idx >> 17);
            const float ph = (float)((c * (np & 255)) & 255) * (1.f / 256.f);
            const float v = (np < 256 ? __builtin_amdgcn_cosf(ph) : -__builtin_amdgcn_sinf(ph)) * gain[g * 256 + c] * (1.f / 1024.f);
            wb[W_DFT + (size_t)j * 524288 + idx] = f2bf(v); }
    }
    unsigned* __restrict__ rope = (unsigned*)(p.ws + WS_ROPE); const int* __restrict__ posp = p.pos;
#pragma unroll 4
    for (size_t idx = gtid; idx < (size_t)T * 128; idx += gstride) {
        const int d = (int)(idx & 127); const int tok = (int)(idx >> 7);
        const float freq = 1.0f / exp2f(13.287712379549449f * ((float)d * (1.0f / 127.0f)));
        const float ang = (float)posp[tok] * freq;
        const double rev = (double)ang * 0.15915494309189535; const float fr = (float)(rev - __builtin_rint(rev));
        h16x2 cs; cs.x = (_Float16)__builtin_amdgcn_cosf(fr); cs.y = (_Float16)__builtin_amdgcn_sinf(fr);
        rope[idx] = __builtin_bit_cast(unsigned, cs);
    }
    const int lane = threadIdx.x & 63; const size_t gw = gtid >> 6, nw = gstride >> 6;
    bf16_t* xb = (bf16_t*)p.out; float* ssq = (float*)(p.ws + WS_SSQ);
#pragma unroll 2
    for (size_t row = gw; row < (size_t)T; row += nw) {
        float s = 0.f;
#pragma unroll
        for (int j = 0; j < 4; ++j) { const size_t off = row * 1024 + j * 256 + lane * 4; const f32x4 v = *(const f32x4*)(p.x + off); s += sum4(v * v);
            u32x2 w; w.x = cvt_pk_bf16(v[0], v[1]); w.y = cvt_pk_bf16(v[2], v[3]); *(u32x2*)(xb + off) = w; }
#pragma unroll
        for (int o = 1; o < 64; o <<= 1) s += __shfl_xor(s, o);
        if (lane < 16) ssq[row * 16 + lane] = lane == 0 ? s : 0.f;
    }
}

constexpr size_t WS_BAR = 243 * MiB;
#define XB_TMO      128
#define XB_XCNT(j)  (256  + 64 * (j))
#define XB_XSUB(j)  (1280 + 64 * (j))
#define XB_XGEN(j)  (2304 + 64 * (j))
#define XB_TOP      3328
#define XB_TOPGEN   3392
#define XCD_BAR_WORDS 3456
#define XB_SPIN_CAP (1u << 20)
__device__ __forceinline__ unsigned xb_ld(unsigned* p)              { return __hip_atomic_load(p, __ATOMIC_RELAXED, __HIP_MEMORY_SCOPE_AGENT); }
__device__ __forceinline__ unsigned xb_add(unsigned* p, unsigned v) { return __hip_atomic_fetch_add(p, v, __ATOMIC_RELAXED, __HIP_MEMORY_SCOPE_AGENT); }
__device__ __forceinline__ unsigned xb_xcc_id() { return (unsigned)__builtin_amdgcn_s_getreg((3 << 11) | 20) & 0xFu; }
#define XB_SPIN(cond, bar) do { unsigned _sp = 0; while (cond) { __builtin_amdgcn_s_sleep(1); \
    if ((++_sp & 255u) == 0u) { if (xb_ld(&(bar)[XB_TMO])) break; if (_sp > XB_SPIN_CAP) { atomicAdd(&(bar)[XB_TMO], 1u); break; } } } } while (0)
__device__ __forceinline__ void xcd_census(unsigned* bar, unsigned x, unsigned& nloc, unsigned& nx) {
    const unsigned G = gridDim.x; unsigned sum, cnt, mine, sp = 0u;
    for (;;) {
        sum = 0u; cnt = 0u; mine = 0u;
#pragma unroll
        for (unsigned j = 0; j < 16; ++j) { const unsigned c = xb_ld(&bar[XB_XCNT(j)]); sum += c; cnt += (c > 0u) ? 1u : 0u; mine = (j == x) ? c : mine; }
        if (sum == G) break;
        __builtin_amdgcn_s_sleep(1);
        if ((++sp & 255u) == 0u) { if (xb_ld(&bar[XB_TMO])) break; if (sp > XB_SPIN_CAP) { atomicAdd(&bar[XB_TMO], 1u); break; } }
    }
    nloc = mine > 0u ? mine : 1u; nx = cnt > 0u ? cnt : 1u;
}
__device__ __forceinline__ void grid_bar(unsigned* bar) {
    asm volatile("s_waitcnt vmcnt(0)" ::: "memory");
    __syncthreads();
    if (threadIdx.x == 0) {
        __builtin_amdgcn_s_waitcnt(0);
        const unsigned x = xb_xcc_id();
        unsigned* mine = bar + XCD_BAR_WORDS + 2 * blockIdx.x;
        unsigned nloc = mine[0], nx = mine[1];
        if (nloc == 0u) { xcd_census(bar, x, nloc, nx); mine[0] = nloc; mine[1] = nx; }
        const unsigned old = xb_add(&bar[XB_XSUB(x)], 1u);
        const unsigned gen = old / nloc;
        if (old + 1u == (gen + 1u) * nloc) {
            __builtin_amdgcn_fence(__ATOMIC_RELEASE, "agent");
            asm volatile("s_waitcnt vmcnt(0)" ::: "memory");
            const unsigned og = xb_add(&bar[XB_TOP], 1u);
            const unsigned tg = og / nx;
            if (og + 1u == (tg + 1u) * nx) xb_add(&bar[XB_TOPGEN], 1u);
            else XB_SPIN(xb_ld(&bar[XB_TOPGEN]) == tg, bar);
            __builtin_amdgcn_fence(__ATOMIC_ACQUIRE, "agent");
            xb_add(&bar[XB_XGEN(x)], 1u);
            asm volatile("s_waitcnt vmcnt(0)" ::: "memory");
        } else {
            XB_SPIN(xb_ld(&bar[XB_XGEN(x)]) == gen, bar);
            __builtin_amdgcn_fence(__ATOMIC_ACQUIRE, "agent");
            asm volatile("s_waitcnt vmcnt(0)" ::: "memory");
        }
    }
    __syncthreads();
}

__global__ void __launch_bounds__(512, 2) fwd_kernel(const Params p) {
    extern __shared__ __attribute__((aligned(16))) unsigned char shm[];
    LAS unsigned char* lds = (LAS unsigned char*)shm;
#define gtid ((size_t)blockIdx.x * 512 + (size_t)tidl)
#define gstride ((size_t)gridDim.x * 512)
#define scr (ws + WS_SCR)
#define xb (xsel ? (bf16_t*)outl : (bf16_t*)(ws + WS_XB))
#define xb_oth (xsel ? (bf16_t*)(ws + WS_XB) : (bf16_t*)outl)
#define wb ((bf16_t*)(ws + WS_W))
#define ssq0 ((float*)(ws + WS_SSQ))
#define ssq1 ((float*)(ws + WS_SSQ) + (size_t)T * 16)
#define gst ((float*)(ws + WS_GST))
#define q_b ((bf16_t*)(scr + R_Q))
#define k_b ((bf16_t*)(scr + R_K))
#define ktf_b ((bf16_t*)(scr + R_KTF))
#define ktb_b ((bf16_t*)(scr + R_KTB))
#define vtc_b ((bf16_t*)(scr + R_VTC))
#define P_b ((bf16_t*)(scr + R_P))
#define rf_b ((bf16_t*)(scr + R_RF))
#define rb_b ((bf16_t*)(scr + R_RB))
#define o_b ((bf16_t*)(scr + R_O))
#define zp_b ((bf16_t*)(scr + Z_ZP))
#define F_b ((bf16_t*)(scr + Z_F))
#define dseq_b ((bf16_t*)(scr + Z_D))
#define H_b ((bf16_t*)(scr + F_H))
#define pp_b ((bf16_t*)(scr + F_PP))
#define pb_b ((bf16_t*)(scr + F_PB))
    int ph = 0, nrm = 0, xsel = 1;
#if COOP
    cg::grid_group grid = cg::this_grid();
    if (threadIdx.x == 0) (void)xb_add(&((unsigned*)(p.ws + WS_BAR))[XB_XCNT(xb_xcc_id())], 1u);
#define PH_BEGIN if (ph >= p.ph_lo && ph < p.ph_hi) { size_t zofs = 0; asm volatile("" : "+s"(zofs)); unsigned char* ws = p.ws + zofs; int tidl = threadIdx.x; asm volatile("" : "+v"(tidl)); float* outl = p.out + zofs;
#define PH_END if (ph + 1 < p.ph_hi) { if (p.ph_hi < 0) grid.sync(); else grid_bar((unsigned*)(p.ws + WS_BAR)); } } ++ph;
#else
#define PH_BEGIN if (ph >= p.ph_lo && ph < p.ph_hi) { size_t zofs = 0; asm volatile("" : "+s"(zofs)); unsigned char* ws = p.ws + zofs; int tidl = threadIdx.x; asm volatile("" : "+v"(tidl)); float* outl = p.out + zofs;
#define PH_END } ++ph;
#endif
#define SSQ_CUR ((nrm & 1) ? ssq1 : ssq0)
#define SSQ_NXT ((nrm & 1) ? ssq0 : ssq1)

    PH_BEGIN if (PHSEL(0)) phase_prep(p); PH_END

    for (int layer = 0; layer < 4; ++layer) {
        const int jj = layer >> 1;
        if ((layer & 1) == 0) {
#define decay (p.ret_decay + (size_t)jj * 8)
            for (int hf = 0; hf < 2; ++hf) {
                const int tok0 = hf * TH;
                PH_BEGIN if (PHSEL(1)) {
                    TileSched S; S.init(xb + (size_t)tok0 * 1024, wb + W_IN + (size_t)jj * 6291456, 1024, 1024, 128, 16);
                    EpiR1 E{SSQ_CUR, (const unsigned*)(ws + WS_ROPE), decay, q_b, k_b, ktf_b, ktb_b, vtc_b, tok0, lds + STAGE_BYTES};
                    gemm_phase(lds, S, E, 1024, 1024, 16);
                } PH_END
                PH_BEGIN if (PHSEL(2)) {
                    const int c = blockIdx.x;
#if !defined(SUB) || SUB == 0
                    { const bool act = c < 128; const int item = act ? c : 0, yy = item >> 3, bh = (item & 7) + 8 * (yy >> 2), dir = (yy >> 1) & 1, half = yy & 1, h = bh & 3;
                      bf16_t* rt = (dir ? rb_b : rf_b) + (size_t)bh * 16 * 131072 + (size_t)half * 65536;
                      if (act) { bf16_t* z = rt + (size_t)(dir ? 15 : 0) * 131072; unsigned zz = 0u; asm volatile("" : "+v"(zz)); for (int i = tidl; i < 8192; i += 512) *(u32x4*)(z + (size_t)i * 8) = (u32x4){zz, zz, zz, zz}; }
                      ScanSched S{(const char*)(vtc_b + (size_t)bh * 16 * 131072 + (size_t)half * 65536), (const char*)((dir ? ktb_b : ktf_b) + (size_t)bh * 16 * 65536), dir, act};
                      EpiScan E{rt, dir, decay + dir * 4 + h};
                      gemm_phase(lds, S, E, 256, 256, 4); }
#endif
#if !defined(SUB) || SUB == 1
                    { ScoreSched S{(const char*)q_b, (const char*)k_b, c >= 128 ? c - 128 : -1, (int)gridDim.x - 128};
                      EpiScore E{decay, P_b};
                      gemm_phase(lds, S, E, 256, 256, 4); }
#endif
                    if (c >= 128) {
                        const size_t g2 = (size_t)(c - 128) * 512 + (size_t)tidl, gs2 = (size_t)128 * 512;
                        if (hf == 0) conv_wt(p.ret_w_out + (size_t)jj * 2048 * 1024, 2048, 1024, wb + W_OUT + (size_t)jj * 2097152, nullptr, 0, 0, 0, 1.f, g2, gs2);
                        else         conv_wt(p.fno_w + (size_t)jj * 1048576, 1024, 1024, wb + W_FNO + (size_t)jj * 1048576, nullptr, 0, 0, 0, 1.f, g2, gs2);
                        conv_layer_ffn(p, wb, layer + hf, g2, gs2);
                        if (layer == 0 && hf == 1) conv_wt(p.ret_w_in + (size_t)1024 * 6144, 1024, 6144, wb + W_IN + (size_t)6291456, p.norm_mix + (size_t)2 * 1024, 0, 1024, 2048, 0.0625f, g2, gs2);
                    }
                } PH_END
                PH_BEGIN if (PHSEL(3)) {
                    OutSched S{(const char*)scr, (int)gridDim.x, (int)blockIdx.x};
                    EpiOut E{decay, o_b, gst};
                    gemm_phase(lds, S, E, 256, 256, 4);
                } PH_END
                PH_BEGIN if (PHSEL(4)) {
                    TileSched S; S.init(xb + (size_t)tok0 * 1024, wb + W_IN + (size_t)jj * 6291456 + (size_t)4096 * 1024, 1024, 1024, 128, 8);
                    EpiGate E{SSQ_CUR, gst, p.ret_gn + (size_t)jj * 2048, o_b, tok0};
                    gemm_phase(lds, S, E, 1024, 1024, 16);
                } PH_END
                PH_BEGIN if (PHSEL(5)) {
                    TileSched S; S.init(o_b, wb + W_OUT + (size_t)jj * 2097152, 2048, 2048, 128, 4);
                    EpiResid<false> E{xb, xb, SSQ_NXT, nullptr, nullptr, tok0, nullptr};
                    gemm_phase(lds, S, E, 2048, 2048, 32);
                } PH_END
            }
            ++nrm;
        } else {
            PH_BEGIN if (PHSEL(6)) {
                for (size_t idx = gtid; idx < (size_t)2048 * 512; idx += gstride) { const int kk = (int)(idx >> 9), c8 = (int)(idx & 511) * 8; const int s0 = c8 & 2047; float v[8];
#pragma unroll
                    for (int i = 0; i < 8; ++i) { const float phs = (float)((kk * (s0 + i)) & 4095) * (1.f / 4096.f); v[i] = c8 < 2048 ? __builtin_amdgcn_cosf(phs) : __builtin_amdgcn_sinf(phs); }
                    u32x4 w; w.x = cvt_pk_bf16(v[0], v[1]); w.y = cvt_pk_bf16(v[2], v[3]); w.z = cvt_pk_bf16(v[4], v[5]); w.w = cvt_pk_bf16(v[6], v[7]);
                    *(u32x4*)(dseq_b + (size_t)kk * 4096 + c8) = w; }
                Z1Sched S{(const char*)(wb + W_DFT + (size_t)jj * 524288), (const char*)xb, (int)gridDim.x, (int)blockIdx.x};
                EpiZ1 E{SSQ_CUR, zp_b};
                gemm_phase(lds, S, E, 256, 1024, 4);
            } PH_END
            PH_BEGIN if (PHSEL(13)) {
                bf16_t* zf = (bf16_t*)(scr + Z_ZF); bf16_t* nyq = (bf16_t*)(scr + Z_NY);
                const int lane = tidl & 63; const size_t gw = gtid >> 6, nw = gstride >> 6;
                for (size_t col = gw; col < 16384; col += nw) { float alt = 0.f;
#pragma unroll 2
                for (int t4 = 0; t4 < 4; ++t4) { const int a = (t4 * 64 + lane) * 8;
                    const bf16_t* zr = zp_b + col * 8192; const bf16_t* zi = zr + 4096;
                    const u32x4 r0 = *(const u32x4*)(zr + a), r1 = *(const u32x4*)(zr + 4088 - a), r2 = *(const u32x4*)(zr + (a ? 4096 - a : 0));
                    const u32x4 i0 = *(const u32x4*)(zi + a), i1 = *(const u32x4*)(zi + 4088 - a), i2 = *(const u32x4*)(zi + (a ? 4096 - a : 0));
                    float dr[8], di[8], mr[8], mi[8];
#pragma unroll
                    for (int j = 0; j < 4; ++j) { dr[2 * j] = bflo(r0[j]); dr[2 * j + 1] = bfhi(r0[j]); di[2 * j] = bflo(i0[j]); di[2 * j + 1] = bfhi(i0[j]); }
#pragma unroll
                    for (int e = 1; e < 8; ++e) { mr[8 - e] = (e & 1) ? bfhi(r1[e >> 1]) : bflo(r1[e >> 1]); mi[8 - e] = (e & 1) ? bfhi(i1[e >> 1]) : bflo(i1[e >> 1]); }
                    mr[0] = a ? bflo(r2[0]) : 0.f; mi[0] = a ? bflo(i2[0]) : 0.f;
                    float er[8], oi[8];
#pragma unroll
                    for (int i = 0; i < 8; ++i) { er[i] = dr[i] + mr[i]; oi[i] = di[i] - mi[i]; }
                    if (a == 0) oi[0] = 0.f;
                    alt += ((er[0] - er[1]) + (er[2] - er[3])) + ((er[4] - er[5]) + (er[6] - er[7]));
                    u32x4 w; w.x = cvt_pk_bf16(er[0], er[1]); w.y = cvt_pk_bf16(er[2], er[3]); w.z = cvt_pk_bf16(er[4], er[5]); w.w = cvt_pk_bf16(er[6], er[7]);
                    *(u32x4*)(zf + col * 4096 + a) = w;
                    u32x4 x; x.x = cvt_pk_bf16(oi[0], oi[1]); x.y = cvt_pk_bf16(oi[2], oi[3]); x.z = cvt_pk_bf16(oi[4], oi[5]); x.w = cvt_pk_bf16(oi[6], oi[7]);
                    *(u32x4*)(zf + col * 4096 + 2048 + a) = x; }
#pragma unroll
                    for (int o2 = 1; o2 < 64; o2 <<= 1) alt += __shfl_xor(alt, o2);
                    if (lane == 0) { const bf16_t zn = zp_b[col * 8192 + 2048]; nyq[col] = zn; F_b[((size_t)(col >> 10) * 4096 + 2048) * 1024 + (col & 1023)] = f2bf(alt + bflo(zn)); } }
            } PH_END
            PH_BEGIN if (PHSEL(7)) {
                Z2Sched S{(const char*)dseq_b, (const char*)(scr + Z_ZF), (int)gridDim.x, (int)blockIdx.x};
                EpiZ2 E{F_b, (float*)(scr + Z_ST) + (size_t)blockIdx.x * 131072, (const bf16_t*)(scr + Z_NY)};
                gemm_phase(lds, S, E, 4096, 4096, 32);
            } PH_END
            PH_BEGIN if (PHSEL(8)) {
                TileSched S; S.init(F_b, wb + W_FNO + (size_t)jj * 1048576, 1024, 1024, 256, 4);
                EpiResid<false> E{xb, xb, SSQ_NXT, nullptr, nullptr, 0, nullptr};
                gemm_phase(lds, S, E, 1024, 1024, 16);
            } PH_END
            ++nrm;
        }
        PH_BEGIN if (PHSEL(9)) {
            TileSched S; S.init(xb, wb + W_GU + (size_t)layer * 5767168, 1024, 1024, 256, 22);
            EpiF1 E{SSQ_CUR, H_b};
            gemm_phase(lds, S, E, 1024, 1024, 16);
            const float* pl = p.p + (size_t)layer * T * 256;
#pragma unroll 4
            for (size_t idx = gtid; idx < (size_t)T * 32; idx += gstride) { const f32x4 a = *(const f32x4*)(pl + idx * 8), b = *(const f32x4*)(pl + idx * 8 + 4);
                u32x4 w; w.x = cvt_pk_bf16(a[0], a[1]); w.y = cvt_pk_bf16(a[2], a[3]); w.z = cvt_pk_bf16(b[0], b[1]); w.w = cvt_pk_bf16(b[2], b[3]); *(u32x4*)(pb_b + idx * 8) = w; }
        } PH_END
        PH_BEGIN if (PHSEL(10)) {
            { TileSched S; S.init(H_b, wb + W_DN + (size_t)layer * 2883584, DFF, DFF, 256, 4);
              EpiResid<false> E{xb, xb, SSQ_NXT, nullptr, nullptr, 0, nullptr};
              gemm_phase(lds, S, E, DFF, DFF, 44); }
            { TileSched S; S.init(pb_b, wb + W_PP + (size_t)layer * 262144, 256, 256, 256, 4);
              EpiPlain<false> E{pp_b, 1024};
              gemm_phase(lds, S, E, 256, 256, 4); }
        } PH_END
        ++nrm;
        PH_BEGIN if (PHSEL(11)) {
            TileSched S; S.init(xb, wb + W_PG + (size_t)layer * 1048576, 1024, 1024, 256, 4);
            EpiResid<true> E{xb, xb_oth, SSQ_NXT, SSQ_CUR, pp_b, 0, layer == 3 ? outl : nullptr};
            gemm_phase(lds, S, E, 1024, 1024, 16);
        } PH_END
        ++nrm; xsel ^= 1;
    }
    PH_BEGIN if (PHSEL(12)) {
        const int lane = tidl & 63; const size_t gw = gtid >> 6, nw = gstride >> 6; const float* ssq = SSQ_CUR;
        for (size_t row = gw; row < (size_t)T; row += nw) {
            float s = lane < 16 ? ssq[row * 16 + lane] : 0.f;
#pragma unroll
            for (int o = 1; o < 16; o <<= 1) s += __shfl_xor(s, o);
            s = __shfl(s, 0);
            const float rs = rsqrtf(s * (1.f / 1024.f) + 1e-6f);
#pragma unroll
            for (int j = 0; j < 4; ++j) { const size_t off = row * 1024 + j * 256 + lane * 4; const f32x4 g = *(const f32x4*)(p.final_norm + j * 256 + lane * 4);
                f32x4 v = *(const f32x4*)(outl + off); v = v * rs * g; *(f32x4*)(outl + off) = v; }
        }
    } PH_END
}

constexpr int LDS_TOTAL = STAGE_BYTES + 32768;
constexpr int N_PHASES = 1 + 2 * (10 + 3) + 2 * (4 + 3) + 1;

extern "C" void kernel_launch(void* const* d_in, const int* in_sizes, int n_in, void* d_out, int out_size, void* d_ws, size_t ws_size, hipStream_t stream) {
    static int ready = 0;
    if (!ready) {
        if (hipFuncSetAttribute((const void*)fwd_kernel, hipFuncAttributeMaxDynamicSharedMemorySize, LDS_TOTAL) != hipSuccess) { fprintf(stderr, "hipFuncSetAttribute failed\n"); ready = -1; return; }
        if (ws_size < 1000 * MiB) { fprintf(stderr, "workspace too small: %zu\n", ws_size); ready = -1; return; }
        ready = 1;
    }
    if (ready < 0) return;
    Params p{};
    p.x = (const float*)d_in[0]; p.p = (const float*)d_in[1]; p.pos = (const int*)d_in[2]; p.norm_mix = (const float*)d_in[3]; p.ret_w_in = (const float*)d_in[4]; p.ret_w_out = (const float*)d_in[5];
    p.ret_gn = (const float*)d_in[6]; p.ret_decay = (const float*)d_in[7]; p.fno_w = (const float*)d_in[8]; p.norm_ffn = (const float*)d_in[9]; p.w_gate = (const float*)d_in[10]; p.w_up = (const float*)d_in[11];
    p.w_down = (const float*)d_in[12]; p.norm_ple = (const float*)d_in[13]; p.ple_wg = (const float*)d_in[14]; p.ple_wp = (const float*)d_in[15]; p.final_norm = (const float*)d_in[16];
    p.out = (float*)d_out; p.ws = (unsigned char*)d_ws;
#if COOP
    p.ph_lo = 0; p.ph_hi = N_PHASES;
    hipMemsetAsync((unsigned char*)d_ws + WS_BAR, 0, (XCD_BAR_WORDS + 2 * 256) * 4, stream);
    void* args[] = {&p};
    hipError_t e = hipLaunchCooperativeKernel((const void*)fwd_kernel, dim3(256), dim3(512), args, LDS_TOTAL, stream);
    if (e != hipSuccess) fprintf(stderr, "cooperative launch failed: %s\n", hipGetErrorString(e));
#else
    for (int ph = 0; ph < N_PHASES; ++ph) { p.ph_lo = ph; p.ph_hi = ph + 1; hipLaunchKernelGGL(fwd_kernel, dim3(256), dim3(512), LDS_TOTAL, stream, p); }
#endif
}
```
